# Optimizing an MI355X kernel written in HIP

```python
import math
import jax, jax.numpy as jnp
from jax import lax
import numpy as np

D_MODEL = 1024
BATCH = 8
SEQ = 2048
DEPTH = 1

CONV_WIDTH = D_MODEL // 2
CONV_K = 3
HEAD_DIM = 64
N_HEADS = (D_MODEL - CONV_WIDTH) // HEAD_DIM
N_KV_HEADS = 2
GQA_GROUP = N_HEADS // N_KV_HEADS
ATTN_WIDTH = N_HEADS * HEAD_DIM
KV_WIDTH = N_KV_HEADS * HEAD_DIM
WINDOW = 128
BLK = 128
NUM_BUCKETS = 32
MAX_DISTANCE = 128
MAX_EXACT = NUM_BUCKETS // 2
D_FF = 2816
FFN_K = 3
EPS = 1e-6
NEG_INF = -1e30
IN_WIDTH = 3 * CONV_WIDTH + ATTN_WIDTH + 2 * KV_WIDTH

kernel_name = "hybrid_shortconv_swa_sink_convffn"


def rms_norm(x, g):
    xf = x.astype(jnp.float32)
    y = xf * lax.rsqrt(jnp.mean(xf * xf, axis=-1, keepdims=True) + EPS)
    return (y * g.astype(jnp.float32)).astype(x.dtype)


def causal_dwconv(x, w):
    K = w.shape[0]
    S = x.shape[1]
    xp = jnp.pad(x, ((0, 0), (K - 1, 0), (0, 0)))
    y = xp[:, 0:S] * w[0]
    for k in range(1, K):
        y = y + xp[:, k:k + S] * w[k]
    return y


def band_offsets():
    q = jnp.arange(BLK, dtype=jnp.int32)[:, None]
    j = jnp.arange(2 * BLK, dtype=jnp.int32)[None, :]
    return q + BLK - j


def t5_band_bias(rel_table, d):
    n = jnp.maximum(d, 0)
    nf = jnp.maximum(n, 1).astype(jnp.float32)
    large = MAX_EXACT + (jnp.log(nf / MAX_EXACT) / math.log(MAX_DISTANCE / MAX_EXACT)
                         * (NUM_BUCKETS - MAX_EXACT)).astype(jnp.int32)
    large = jnp.minimum(large, NUM_BUCKETS - 1)
    bucket = jnp.where(n < MAX_EXACT, n, large)
    bias = rel_table[bucket].astype(jnp.float32)
    return bias.transpose(2, 0, 1).reshape(N_KV_HEADS, GQA_GROUP, BLK, 2 * BLK)


def band_blocks(t):
    Bn, S = t.shape[0], t.shape[1]
    nb = S // BLK
    tb = t.reshape(Bn, nb, BLK, N_KV_HEADS, HEAD_DIM)
    prev = jnp.pad(tb, ((0, 0), (1, 0), (0, 0), (0, 0), (0, 0)))[:, :-1]
    return jnp.concatenate([prev, tb], axis=2)


def sliding_window_attention(q, k, v, sinks, bias, d):
    Bn, S = q.shape[0], q.shape[1]
    nb = S // BLK
    qb = q.reshape(Bn, nb, BLK, N_KV_HEADS, GQA_GROUP, HEAD_DIM)
    kband = band_blocks(k)
    vband = band_blocks(v)
    scale = HEAD_DIM ** -0.5
    logits = jnp.einsum('bnqhgd,bnkhd->bnhgqk', qb, kband).astype(jnp.float32) * scale + bias
    within = (d >= 0) & (d < WINDOW)
    key_pos = (jnp.arange(nb, dtype=jnp.int32)[:, None, None] - 1) * BLK \
        + jnp.arange(2 * BLK, dtype=jnp.int32)[None, None, :]
    valid = within[None] & (key_pos >= 0)
    logits = jnp.where(valid[None, :, None, None], logits, NEG_INF)
    sink = sinks.astype(jnp.float32).reshape(1, 1, N_KV_HEADS, GQA_GROUP, 1, 1)
    m = jnp.maximum(jnp.max(logits, axis=-1, keepdims=True), sink)
    p = jnp.exp(logits - m)
    denom = jnp.sum(p, axis=-1, keepdims=True) + jnp.exp(sink - m)
    probs = (p / denom).astype(v.dtype)
    out = jnp.einsum('bnhgqk,bnkhd->bnqhgd', probs, vband)
    return out.reshape(Bn, S, ATTN_WIDTH)


def setup_inputs(seed: int = 0) -> dict:
    key = jax.random.key(seed)
    ks = jax.random.split(key, 17)
    f32 = jnp.float32

    def nrm(k, shape, scale):
        return jax.random.normal(k, shape, f32) * scale

    def gain(k, shape):
        return 1.0 + 0.02 * jax.random.normal(k, shape, f32)

    return {
        "x": jax.random.normal(ks[0], (BATCH, SEQ, D_MODEL), f32),
        "norm_mix_g": gain(ks[1], (DEPTH, D_MODEL)),
        "w_in": nrm(ks[2], (DEPTH, D_MODEL, IN_WIDTH), D_MODEL ** -0.5),
        "conv_w": nrm(ks[3], (DEPTH, CONV_K, CONV_WIDTH), CONV_K ** -0.5),
        "q_norm_g": gain(ks[4], (DEPTH, HEAD_DIM)),
        "k_norm_g": gain(ks[5], (DEPTH, HEAD_DIM)),
        "rel_bias_table": nrm(ks[6], (NUM_BUCKETS, N_HEADS), 0.5),
        "sinks": nrm(ks[7], (DEPTH, N_HEADS), 1.0),
        "out_norm_conv_g": gain(ks[8], (DEPTH, CONV_WIDTH)),
        "out_norm_attn_g": gain(ks[9], (DEPTH, ATTN_WIDTH)),
        "w_out": nrm(ks[10], (DEPTH, CONV_WIDTH + ATTN_WIDTH, D_MODEL), (CONV_WIDTH + ATTN_WIDTH) ** -0.5),
        "norm_ffn_g": gain(ks[11], (DEPTH, D_MODEL)),
        "w_up": nrm(ks[12], (DEPTH, D_MODEL, 2 * D_FF), D_MODEL ** -0.5),
        "ffn_conv_w": nrm(ks[13], (DEPTH, FFN_K, 2 * D_FF), FFN_K ** -0.5),
        "ffn_conv_b": nrm(ks[14], (DEPTH, 2 * D_FF), 0.02),
        "w_down": nrm(ks[15], (DEPTH, D_FF, D_MODEL), D_FF ** -0.5),
    }


def reference(x, norm_mix_g, w_in, conv_w, q_norm_g, k_norm_g, rel_bias_table, sinks,
              out_norm_conv_g, out_norm_attn_g, w_out, norm_ffn_g, w_up, ffn_conv_w,
              ffn_conv_b, w_down):
    Bn, S, _ = x.shape
    d = band_offsets()
    bias = t5_band_bias(rel_bias_table, d)
    h = x
    for l in range(DEPTH):
        u = rms_norm(h, norm_mix_g[l])
        proj = jnp.einsum('bsd,de->bse', u, w_in[l])
        c0 = 0
        gate_b = proj[..., c0:c0 + CONV_WIDTH]; c0 += CONV_WIDTH
        gate_c = proj[..., c0:c0 + CONV_WIDTH]; c0 += CONV_WIDTH
        hc = proj[..., c0:c0 + CONV_WIDTH]; c0 += CONV_WIDTH
        q = proj[..., c0:c0 + ATTN_WIDTH]; c0 += ATTN_WIDTH
        k = proj[..., c0:c0 + KV_WIDTH]; c0 += KV_WIDTH
        v = proj[..., c0:c0 + KV_WIDTH]

        y_conv = gate_b * causal_dwconv(gate_c * hc, conv_w[l])

        q = rms_norm(q.reshape(Bn, S, N_HEADS, HEAD_DIM), q_norm_g[l])
        k = rms_norm(k.reshape(Bn, S, N_KV_HEADS, HEAD_DIM), k_norm_g[l])
        v = v.reshape(Bn, S, N_KV_HEADS, HEAD_DIM)
        y_attn = sliding_window_attention(q, k, v, sinks[l], bias, d)

        y = jnp.concatenate([rms_norm(y_conv, out_norm_conv_g[l]),
                             rms_norm(y_attn, out_norm_attn_g[l])], axis=-1)
        h = h + jnp.einsum('bse,ed->bsd', y, w_out[l])

        u = rms_norm(h, norm_ffn_g[l])
        up = jnp.einsum('bsd,df->bsf', u, w_up[l])
        up = causal_dwconv(up, ffn_conv_w[l]) + ffn_conv_b[l]
        g, val = up[..., :D_FF], up[..., D_FF:]
        h = h + jnp.einsum('bsf,fd->bsd', jax.nn.silu(g) * val, w_down[l])
    return h
```

```cpp
#include <hip/hip_runtime.h>
#include <cstdint>
#include <cstdio>

typedef unsigned short bf16_t;
typedef short bf16x8 __attribute__((ext_vector_type(8)));
typedef float f32x4 __attribute__((ext_vector_type(4)));

constexpr int D = 1024, BATCH = 8, SEQ = 2048, M = BATCH * SEQ;
constexpr int CW = 512, HD = 64, NH = 8, NKV = 2, AW = 512, KVW = 128, INW = 2304, DFF = 2816, NUP = 2 * DFF;
constexpr int C_GB = 0, C_GC = 512, C_HC = 1024, C_Q = 1536, C_K = 2048, C_V = 2176;
constexpr float EPS = 1e-6f;

constexpr size_t MiB = 1u << 20;
constexpr size_t WS_CTL = 0;
constexpr size_t WS_WIN = 2 * MiB;
constexpr size_t WS_WOUT = 7 * MiB;
constexpr size_t WS_WUP = 9 * MiB;
constexpr size_t WS_WDOWN = 20 * MiB;
constexpr size_t WS_SSQ = 26 * MiB;
constexpr size_t WS_XN = 32 * MiB;
constexpr size_t WS_PROJ = 64 * MiB;
constexpr size_t WS_Y = 136 * MiB;
constexpr size_t WS_YA = 168 * MiB;
constexpr size_t WS_UPH = 64 * MiB;
constexpr size_t WS_ACT = 152 * MiB;

__device__ __forceinline__ unsigned f2bf(float f) { unsigned u = __builtin_bit_cast(unsigned, f); return (u + 0x7fffu + ((u >> 16) & 1u)) >> 16; }
__device__ __forceinline__ float bf2f(bf16_t h) { return __builtin_bit_cast(float, (unsigned)h << 16); }
__device__ __forceinline__ float wave_sum(float v) {
#pragma unroll
    for (int o = 1; o < 64; o <<= 1) v += __shfl_xor(v, o);
    return v;
}
__device__ __forceinline__ float wave_max(float v) {
#pragma unroll
    for (int o = 1; o < 64; o <<= 1) v = fmaxf(v, __shfl_xor(v, o));
    return v;
}

__host__ __device__ __forceinline__ int up_src_col(int np) { const int pn = np >> 8, w = np & 255, bj = w >> 7, c = w & 127; return bj * DFF + pn * 128 + c; }

template <int MODE>
__global__ void __launch_bounds__(256) k_prep(const float* __restrict__ W, const float* __restrict__ scale, bf16_t* __restrict__ out, int K, int N) {
    __shared__ float tile[32][33];
    const int n0 = blockIdx.x * 32, k0 = blockIdx.y * 32, tx = threadIdx.x & 31, ty = threadIdx.x >> 5;
    for (int i = ty; i < 32; i += 8) {
        const int k = k0 + i, n = n0 + tx, src = MODE == 1 ? up_src_col(n) : n;
        tile[i][tx] = W[(size_t)k * N + src] * (scale ? scale[k] : 1.f);
    }
    __syncthreads();
    for (int i = ty; i < 32; i += 8) { const int n = n0 + i, k = k0 + tx; out[(size_t)n * K + k] = (bf16_t)f2bf(tile[tx][i]); }
}

__global__ void __launch_bounds__(256) k_rms_x(const float* __restrict__ x, bf16_t* __restrict__ xn) {
    const int row = blockIdx.x * 4 + (threadIdx.x >> 6), lane = threadIdx.x & 63;
    const f32x4* xr = (const f32x4*)(x + (size_t)row * D) + lane;
    f32x4 v[4]; float s = 0.f;
#pragma unroll
    for (int j = 0; j < 4; ++j) { v[j] = xr[64 * j]; s += (v[j].x * v[j].x + v[j].y * v[j].y) + (v[j].z * v[j].z + v[j].w * v[j].w); }
    const float rstd = 1.0f / sqrtf(wave_sum(s) * (1.f / D) + EPS);
    unsigned long long* o8 = (unsigned long long*)(xn + (size_t)row * D) + lane;
#pragma unroll
    for (int j = 0; j < 4; ++j) {
        const unsigned lo = f2bf(v[j].x * rstd) | (f2bf(v[j].y * rstd) << 16), hi = f2bf(v[j].z * rstd) | (f2bf(v[j].w * rstd) << 16);
        o8[64 * j] = (unsigned long long)lo | ((unsigned long long)hi << 32);
    }
}

template <class Epi>
__global__ void __launch_bounds__(256) k_gemm_naive(const bf16_t* __restrict__ A, const bf16_t* __restrict__ Bt, int K, Epi epi) {
    const int wid = threadIdx.x >> 6, lane = threadIdx.x & 63;
    const int m0 = blockIdx.y * 128 + (wid >> 1) * 64, n0 = blockIdx.x * 128 + (wid & 1) * 64;
    f32x4 acc[4][4];
#pragma unroll
    for (int i = 0; i < 4; ++i)
#pragma unroll
        for (int j = 0; j < 4; ++j) acc[i][j] = (f32x4){0.f, 0.f, 0.f, 0.f};
    const bf16_t* ap = A + (size_t)(m0 + (lane & 15)) * K + 8 * (lane >> 4);
    const bf16_t* bp = Bt + (size_t)(n0 + (lane & 15)) * K + 8 * (lane >> 4);
    for (int k0 = 0; k0 < K; k0 += 32) {
        bf16x8 a[4], b[4];
#pragma unroll
        for (int i = 0; i < 4; ++i) { a[i] = *(const bf16x8*)(ap + (size_t)i * 16 * K + k0); b[i] = *(const bf16x8*)(bp + (size_t)i * 16 * K + k0); }
#pragma unroll
        for (int i = 0; i < 4; ++i)
#pragma unroll
            for (int j = 0; j < 4; ++j) acc[i][j] = __builtin_amdgcn_mfma_f32_16x16x32_bf16(a[i], b[j], acc[i][j], 0, 0, 0);
    }
#pragma unroll
    for (int i = 0; i < 4; ++i)
#pragma unroll
        for (int j = 0; j < 4; ++j)
#pragma unroll
            for (int r = 0; r < 4; ++r) epi(m0 + i * 16 + 4 * (lane >> 4) + r, n0 + j * 16 + (lane & 15), acc[i][j][r]);
}
struct EpiStoreBf16 { bf16_t* O; int ldc; int pad; __device__ void operator()(int r, int c, float v) const { O[(size_t)r * ldc + c] = (bf16_t)f2bf(v); } };
struct EpiResid { const float* base; float* out; __device__ void operator()(int r, int c, float v) const { out[(size_t)r * D + c] = base[(size_t)r * D + c] + v; } };
struct EpiUpPre { bf16_t* O; const float* ssq; int row_off; int pad; __device__ void operator()(int r, int c, float v) const {
    const float* s = ssq + (size_t)(r + row_off) * 4; const float rstd = 1.0f / sqrtf(((s[0] + s[1]) + (s[2] + s[3])) * (1.f / D) + EPS);
    O[(size_t)r * NUP + c] = (bf16_t)f2bf(v * rstd); } };

__global__ void __launch_bounds__(256) k_conv_qk(bf16_t* __restrict__ proj, const float* __restrict__ conv_w, const float* __restrict__ gconv,
                                                const float* __restrict__ qg, const float* __restrict__ kg, bf16_t* __restrict__ Y) {
    __shared__ float red[4];
    const int t = blockIdx.x, tid = threadIdx.x, lane = tid & 63, wid = tid >> 6, s = t % SEQ;
    bf16_t* pr = proj + (size_t)t * INW;
    float yc[2]; float ss = 0.f;
#pragma unroll
    for (int e = 0; e < 2; ++e) {
        const int c = tid + 256 * e; float acc = 0.f;
#pragma unroll
        for (int k = 0; k < 3; ++k) { const int dt = 2 - k; if (s - dt >= 0) { const bf16_t* p2 = pr - (size_t)dt * INW; acc += conv_w[k * CW + c] * (bf2f(p2[C_GC + c]) * bf2f(p2[C_HC + c])); } }
        yc[e] = bf2f(pr[C_GB + c]) * acc; ss += yc[e] * yc[e];
    }
    ss = wave_sum(ss); if (lane == 0) red[wid] = ss; __syncthreads();
    const float rstd = 1.0f / sqrtf(((red[0] + red[1]) + (red[2] + red[3])) * (1.f / CW) + EPS);
#pragma unroll
    for (int e = 0; e < 2; ++e) { const int c = tid + 256 * e; Y[(size_t)t * D + c] = (bf16_t)f2bf(yc[e] * rstd * gconv[c]); }
#pragma unroll
    for (int e = 0; e < 2; ++e) { const int idx = tid + 256 * e; const float q = bf2f(pr[C_Q + idx]); const float r = 1.0f / sqrtf(wave_sum(q * q) * (1.f / HD) + EPS); pr[C_Q + idx] = (bf16_t)f2bf(q * r * qg[lane]); }
    if (tid < 128) { const float k = bf2f(pr[C_K + tid]); const float r = 1.0f / sqrtf(wave_sum(k * k) * (1.f / HD) + EPS); pr[C_K + tid] = (bf16_t)f2bf(k * r * kg[lane]); }
}

__device__ __forceinline__ int t5_bucket(int d) {
    if (d < 16) return d;
    int b = 16 + (int)(logf((float)d / 16.f) / 2.0794415416798357f * 16.f);
    return b < 31 ? b : 31;
}

__global__ void __launch_bounds__(256) k_attn_naive(const bf16_t* __restrict__ proj, const float* __restrict__ rel, const float* __restrict__ sinks, float* __restrict__ ya) {
    const int t = blockIdx.x, kvh = blockIdx.y, wid = threadIdx.x >> 6, lane = threadIdx.x & 63, h = kvh * 4 + wid, s = t % SEQ;
    const bf16_t* qrow = proj + (size_t)t * INW + C_Q + h * HD;
    float lg[2];
#pragma unroll
    for (int e = 0; e < 2; ++e) {
        const int j = lane + 64 * e;
        lg[e] = -1e30f;
        if (s - j >= 0) {
            const bf16_t* krow = proj + (size_t)(t - j) * INW + C_K + kvh * HD; float dot = 0.f;
            for (int d = 0; d < HD; ++d) dot += bf2f(qrow[d]) * bf2f(krow[d]);
            lg[e] = dot * 0.125f + rel[t5_bucket(j) * NH + h];
        }
    }
    const float sink = sinks[h];
    const float m = fmaxf(wave_max(fmaxf(lg[0], lg[1])), sink);
    float p[2]; p[0] = lg[0] > -1e29f ? expf(lg[0] - m) : 0.f; p[1] = lg[1] > -1e29f ? expf(lg[1] - m) : 0.f;
    const float denom = wave_sum(p[0] + p[1]) + expf(sink - m);
    float o = 0.f;
    for (int j = 0; j < 128; ++j) {
        const float pj = __shfl(j < 64 ? p[0] : p[1], j & 63);
        if (s - j >= 0) o += pj * bf2f(proj[(size_t)(t - j) * INW + C_V + kvh * HD + lane]);
    }
    ya[(size_t)t * AW + h * HD + lane] = o / denom;
}
__global__ void __launch_bounds__(256) k_attn_outnorm(const float* __restrict__ ya, const float* __restrict__ gattn, bf16_t* __restrict__ Y) {
    __shared__ float red[4];
    const int t = blockIdx.x, tid = threadIdx.x, lane = tid & 63, wid = tid >> 6;
    const float a = ya[(size_t)t * AW + tid], b = ya[(size_t)t * AW + tid + 256];
    float ss = wave_sum(a * a + b * b); if (lane == 0) red[wid] = ss; __syncthreads();
    const float rstd = 1.0f / sqrtf(((red[0] + red[1]) + (red[2] + red[3])) * (1.f / AW) + EPS);
    Y[(size_t)t * D + CW + tid] = (bf16_t)f2bf(a * rstd * gattn[tid]); Y[(size_t)t * D + CW + tid + 256] = (bf16_t)f2bf(b * rstd * gattn[tid + 256]);
}
__global__ void __launch_bounds__(256) k_rms_h(const float* __restrict__ hbuf, bf16_t* __restrict__ hb, float* __restrict__ ssq) {
    const int row = blockIdx.x * 4 + (threadIdx.x >> 6), lane = threadIdx.x & 63;
    const f32x4* xr = (const f32x4*)(hbuf + (size_t)row * D) + lane;
    f32x4 v[4]; float s = 0.f;
#pragma unroll
    for (int j = 0; j < 4; ++j) { v[j] = xr[64 * j]; s += (v[j].x * v[j].x + v[j].y * v[j].y) + (v[j].z * v[j].z + v[j].w * v[j].w); }
    s = wave_sum(s);
    if (lane < 4) ssq[(size_t)row * 4 + lane] = lane == 0 ? s : 0.f;
    unsigned long long* o8 = (unsigned long long*)(hb + (size_t)row * D) + lane;
#pragma unroll
    for (int j = 0; j < 4; ++j) {
        const unsigned lo = f2bf(v[j].x) | (f2bf(v[j].y) << 16), hi = f2bf(v[j].z) | (f2bf(v[j].w) << 16);
        o8[64 * j] = (unsigned long long)lo | ((unsigned long long)hi << 32);
    }
}
__global__ void __launch_bounds__(256) k_convact(const bf16_t* __restrict__ uph, const float* __restrict__ fw, const float* __restrict__ fb, bf16_t* __restrict__ act, int row_off) {
    const int tl = blockIdx.x, t = tl + row_off, s = t % SEQ;
    for (int ch = threadIdx.x; ch < DFF; ch += 256) {
        const int pn = ch >> 7, c = ch & 127, colg = pn * 256 + c, colv = colg + 128;
        float g = fb[ch], v = fb[DFF + ch];
#pragma unroll
        for (int k = 0; k < 3; ++k) { const int dt = 2 - k; if (s - dt >= 0) { const bf16_t* p = uph + (size_t)(tl - dt) * NUP; g += fw[k * NUP + ch] * bf2f(p[colg]); v += fw[k * NUP + DFF + ch] * bf2f(p[colv]); } }
        const float sg = g / (1.f + expf(-g));
        act[(size_t)t * DFF + ch] = (bf16_t)f2bf(sg * v);
    }
}

extern "C" void kernel_launch(void* const* d_in, const int* in_sizes, int n_in, void* d_out, int out_size, void* d_ws, size_t ws_size, hipStream_t stream) {
    const float* x = (const float*)d_in[0]; const float* g_mix = (const float*)d_in[1]; const float* w_in = (const float*)d_in[2]; const float* conv_w = (const float*)d_in[3];
    const float* qg = (const float*)d_in[4]; const float* kg = (const float*)d_in[5]; const float* rel = (const float*)d_in[6]; const float* sinks = (const float*)d_in[7];
    const float* gconv = (const float*)d_in[8]; const float* gattn = (const float*)d_in[9]; const float* w_out = (const float*)d_in[10]; const float* g_ffn = (const float*)d_in[11];
    const float* w_up = (const float*)d_in[12]; const float* fw = (const float*)d_in[13]; const float* fb = (const float*)d_in[14]; const float* w_down = (const float*)d_in[15];
    unsigned char* ws = (unsigned char*)d_ws; float* out = (float*)d_out;
    bf16_t* Win_t = (bf16_t*)(ws + WS_WIN); bf16_t* Wout_t = (bf16_t*)(ws + WS_WOUT); bf16_t* Wup_t = (bf16_t*)(ws + WS_WUP); bf16_t* Wdown_t = (bf16_t*)(ws + WS_WDOWN);
    float* ssq = (float*)(ws + WS_SSQ); bf16_t* XN = (bf16_t*)(ws + WS_XN); bf16_t* PROJ = (bf16_t*)(ws + WS_PROJ); bf16_t* Y = (bf16_t*)(ws + WS_Y);
    float* YA = (float*)(ws + WS_YA); bf16_t* UPH = (bf16_t*)(ws + WS_UPH); bf16_t* ACT = (bf16_t*)(ws + WS_ACT);

    k_prep<0><<<dim3(INW / 32, D / 32), 256, 0, stream>>>(w_in, g_mix, Win_t, D, INW);
    k_prep<0><<<dim3(D / 32, D / 32), 256, 0, stream>>>(w_out, nullptr, Wout_t, D, D);
    k_prep<1><<<dim3(NUP / 32, D / 32), 256, 0, stream>>>(w_up, g_ffn, Wup_t, D, NUP);
    k_prep<0><<<dim3(D / 32, DFF / 32), 256, 0, stream>>>(w_down, nullptr, Wdown_t, DFF, D);
    k_rms_x<<<M / 4, 256, 0, stream>>>(x, XN);
    k_gemm_naive<EpiStoreBf16><<<dim3(INW / 128, M / 128), 256, 0, stream>>>(XN, Win_t, D, EpiStoreBf16{PROJ, INW, 0});
    k_conv_qk<<<M, 256, 0, stream>>>(PROJ, conv_w, gconv, qg, kg, Y);
    k_attn_naive<<<dim3(M, NKV), 256, 0, stream>>>(PROJ, rel, sinks, YA);
    k_attn_outnorm<<<M, 256, 0, stream>>>(YA, gattn, Y);
    k_gemm_naive<EpiResid><<<dim3(D / 128, M / 128), 256, 0, stream>>>(Y, Wout_t, D, EpiResid{x, out});
    k_rms_h<<<M / 4, 256, 0, stream>>>(out, XN, ssq);
    for (int half = 0; half < 2; ++half) {
        const int ro = half * (M / 2);
        k_gemm_naive<EpiUpPre><<<dim3(NUP / 128, M / 2 / 128), 256, 0, stream>>>(XN + (size_t)ro * D, Wup_t, D, EpiUpPre{UPH, ssq, ro, 0});
        k_convact<<<M / 2, 256, 0, stream>>>(UPH, fw, fb, ACT, ro);
    }
    k_gemm_naive<EpiResid><<<dim3(D / 128, M / 128), 256, 0, stream>>>(ACT, Wdown_t, DFF, EpiResid{out, out});
}
```

```cpp
#include <hip/hip_runtime.h>
#include <cstdio>
#include <cstdint>
__device__ __forceinline__ int lane_id_fresh() { int l; asm volatile("v_mbcnt_lo_u32_b32 %0, -1, 0\n\tv_mbcnt_hi_u32_b32 %0, -1, %0" : "=v"(l)); return l; }
namespace pg8 {
#define PG8_LAS __attribute__((address_space(3)))
typedef unsigned short bf16_t;
typedef short bf16x8 __attribute__((ext_vector_type(8)));
typedef float f32x4 __attribute__((ext_vector_type(4)));
typedef unsigned u32x4 __attribute__((ext_vector_type(4)));
constexpr int BM = 256, BK = 64, HALF = 128, HTB = HALF * BK * 2  , STAGE_BYTES = 8 * HTB, NXCD = 8, WGM = 8;

__host__ __device__ __forceinline__ int lds_byte(int r, int c) { const int st = (r >> 4) * 2 + (c >> 5), rr = r & 15, cc = c & 31, ob = rr * 64 + cc * 2; return st * 1024 + (ob ^ (((ob >> 9) & 1) << 5)); }
__host__ __device__ __forceinline__ void stage_rc(int b, int& R, int& C) { const int st = b / 1024, sb = b % 1024, swz = sb ^ (((sb >> 9) & 1) << 5); R = (st >> 1) * 16 + swz / 64; C = (st & 1) * 32 + (swz % 64) / 2; }
__host__ __device__ __forceinline__ int perm32(int rho) { const int n = rho >> 4, i = rho & 15; return 8 * (i >> 2) + 4 * n + (i & 3); }

struct Unit { int pm, pn; };
struct Gemm { const bf16_t* A; const bf16_t* Bt; int M, N, K; };

struct StaticOrder {
    int nM, nN, nwg, G, c;
    __host__ __device__ void init(int M, int N, int G_, int c_) { nM = M / BM; nN = N / BM; nwg = nM * nN; G = G_; c = c_; }
    __host__ __device__ bool next(int i, Unit& u) const {
        const long L = (long)i * G + c; if (L >= nwg) return false;
        int wgid = (int)L; { const int q = nwg / NXCD, r = nwg % NXCD, xcd = wgid % NXCD, off = wgid / NXCD; wgid = (xcd < r ? xcd * (q + 1) : r * (q + 1) + (xcd - r) * q) + off; }
        const int nig = WGM * nN, gid = wgid / nig, fm = gid * WGM, gsz = (nM - fm) < WGM ? (nM - fm) : WGM;
        u.pm = fm + ((wgid % nig) % gsz); u.pn = (wgid % nig) / gsz; return true;
    }
    __device__ __forceinline__ void a_ready(const Unit&) const {}
    __device__ __forceinline__ void done(const Unit&) const {}
};

__device__ __forceinline__ unsigned cvt_pk_bf16(float lo, float hi) { unsigned r; asm volatile("v_cvt_pk_bf16_f32 %0, %1, %2" : "=v"(r) : "v"(lo), "v"(hi)); return r; }
typedef float f32x2 __attribute__((ext_vector_type(2)));
struct EpiBf16P {
    static constexpr bool PERM = true, AFTER_DRAIN = false;
    static constexpr int SP = 528;
    bf16_t* O; int ldc; PG8_LAS unsigned char* slab;
    __device__ __forceinline__ void operator()(const f32x4 (&acc)[2][2][4][2], const Unit& u, int wr, int wc, int fr_, int fq_) const {
        int fr = fr_, fq = fq_; asm volatile("" : "+v"(fr), "+v"(fq));
        const int tid = (wr * 4 + wc) * 64 + fq * 16 + fr, rr = tid >> 5, ch = tid & 31;
        PG8_LAS unsigned char* wp = slab + (wr * 16 + fr) * SP + wc * 64 + fq * 16;
        const PG8_LAS unsigned char* rp = slab + rr * SP + ch * 16;
        bf16_t* gp = O + (size_t)(u.pm * BM + rr) * ldc + u.pn * BM + ch * 8;
#pragma unroll
        for (int ai = 0; ai < 2; ++ai)
#pragma unroll
            for (int m = 0; m < 4; ++m) {
#pragma unroll
                for (int bj = 0; bj < 2; ++bj) { const f32x4 v0 = acc[ai][bj][m][0], v1 = acc[ai][bj][m][1];
                    u32x4 w; w.x = cvt_pk_bf16(v0[0], v0[1]); w.y = cvt_pk_bf16(v0[2], v0[3]); w.z = cvt_pk_bf16(v1[0], v1[1]); w.w = cvt_pk_bf16(v1[2], v1[3]);
                    *(PG8_LAS u32x4*)(wp + bj * 256) = w; }
                asm volatile("s_waitcnt lgkmcnt(0)" ::: "memory"); __builtin_amdgcn_s_barrier(); asm volatile("" ::: "memory");
                const u32x4 a = *(const PG8_LAS u32x4*)rp, b = *(const PG8_LAS u32x4*)(rp + 16 * SP);
                *(u32x4*)(gp + (size_t)(ai * HALF + m * 16) * ldc) = a; *(u32x4*)(gp + (size_t)(ai * HALF + m * 16 + 64) * ldc) = b;
                asm volatile("s_waitcnt lgkmcnt(0)" ::: "memory"); __builtin_amdgcn_s_barrier(); asm volatile("" ::: "memory");
            }
    }
};
struct EpiBf16Rs {
    static constexpr bool PERM = true, AFTER_DRAIN = false;
    bf16_t* O; int ldc; const float* ssq; int row_off;
    __device__ __forceinline__ void operator()(const f32x4 (&acc)[2][2][4][2], const Unit& u, int wr, int wc, int fr, int fq) const {
        const int row0 = u.pm * BM + wr * 64 + fr, col0 = u.pn * BM + wc * 32 + 8 * fq;
#pragma unroll
        for (int ai = 0; ai < 2; ++ai)
#pragma unroll
            for (int m = 0; m < 4; ++m) { const int row = row0 + ai * HALF + m * 16; bf16_t* rowp = O + (size_t)row * ldc + col0;
                const f32x4 s = *(const f32x4*)(ssq + (size_t)(row + row_off) * 4); const float rs = 1.0f / sqrtf(((s[0] + s[1]) + (s[2] + s[3])) * (1.0f / 1024.0f) + 1e-6f);
#pragma unroll
                for (int bj = 0; bj < 2; ++bj) { const f32x4 v0 = acc[ai][bj][m][0] * rs, v1 = acc[ai][bj][m][1] * rs;
                    u32x4 w; w.x = cvt_pk_bf16(v0[0], v0[1]); w.y = cvt_pk_bf16(v0[2], v0[3]); w.z = cvt_pk_bf16(v1[0], v1[1]); w.w = cvt_pk_bf16(v1[2], v1[3]);
                    *(u32x4*)(rowp + bj * HALF) = w; } }
    }
};
struct EpiResH {
    static constexpr bool PERM = false, AFTER_DRAIN = true;
    const float* base; bf16_t* hb; float* ssq; int ldc;
    __device__ __forceinline__ void fused(f32x4 (&acc)[2][2][4][2], const Unit& u, int wr, int wc, int fr, int fq, PG8_LAS unsigned char* lds, int wid, int lane) const {
        typedef unsigned u32x2v __attribute__((ext_vector_type(2)));
        PG8_LAS float* P = (PG8_LAS float*)lds;
        const int col0 = u.pn * BM + wc * 32 + 4 * fq;
#pragma unroll
        for (int ai = 0; ai < 2; ++ai)
#pragma unroll
            for (int m = 0; m < 4; ++m) { const int r = ai * HALF + wr * 64 + m * 16 + fr; const size_t off = (size_t)(u.pm * BM + r) * ldc + col0; float q = 0.f;
#pragma unroll
                for (int bj = 0; bj < 2; ++bj)
#pragma unroll
                    for (int n = 0; n < 2; ++n) { const f32x4 hv = *(const f32x4*)(base + off + bj * HALF + n * 16) + acc[ai][bj][m][n];
                        q += (hv[0] * hv[0] + hv[1] * hv[1]) + (hv[2] * hv[2] + hv[3] * hv[3]);
                        u32x2v w; w.x = cvt_pk_bf16(hv[0], hv[1]); w.y = cvt_pk_bf16(hv[2], hv[3]); *(u32x2v*)(hb + off + bj * HALF + n * 16) = w; }
                q += __shfl_xor(q, 16); q += __shfl_xor(q, 32);
                if (fq == 0) P[r * 4 + wc] = q;
                if (m & 1) asm volatile("" ::: "memory"); }
        asm volatile("s_waitcnt lgkmcnt(0)" ::: "memory"); __builtin_amdgcn_s_barrier(); asm volatile("" ::: "memory");
        const int tid = wid * 64 + lane;
        if (tid < 256) { const f32x4 p = *(const PG8_LAS f32x4*)(P + tid * 4); ssq[(size_t)(u.pm * BM + tid) * 4 + u.pn] = (p[0] + p[1]) + (p[2] + p[3]); }
    }
};
struct EpiResOut {
    static constexpr bool PERM = false, AFTER_DRAIN = false;
    float* out; const bf16_t* hb; int ldc;
    __device__ __forceinline__ void operator()(const f32x4 (&acc)[2][2][4][2], const Unit& u, int wr, int wc, int fr, int fq) const {
        typedef unsigned u32x2v __attribute__((ext_vector_type(2)));
        const int row0 = u.pm * BM + wr * 64 + fr, col0 = u.pn * BM + wc * 32 + 4 * fq;
#pragma unroll
        for (int ai = 0; ai < 2; ++ai)
#pragma unroll
            for (int m = 0; m < 4; ++m) { const size_t off = (size_t)(row0 + ai * HALF + m * 16) * ldc + col0;
#pragma unroll
                for (int bj = 0; bj < 2; ++bj)
#pragma unroll
                    for (int n = 0; n < 2; ++n) { const u32x2v w = *(const u32x2v*)(hb + off + bj * HALF + n * 16);
                        f32x4 hv; hv[0] = __builtin_bit_cast(float, w.x << 16); hv[1] = __builtin_bit_cast(float, w.x & 0xffff0000u); hv[2] = __builtin_bit_cast(float, w.y << 16); hv[3] = __builtin_bit_cast(float, w.y & 0xffff0000u);
                        *(f32x4*)(out + off + bj * HALF + n * 16) = hv + acc[ai][bj][m][n]; }
                if (m & 1) asm volatile("" ::: "memory"); }
    }
};
template <int CTRL> __device__ __forceinline__ f32x4 dpp4(const f32x4 v) {
    f32x4 r;
#pragma unroll
    for (int e = 0; e < 4; ++e) { const float t = v[e]; const int ti = __builtin_bit_cast(int, t);
        const int ri = __builtin_amdgcn_update_dpp(0, ti, CTRL, 0xf, 0xf, false); const float rf = __builtin_bit_cast(float, ri); r[e] = rf; }
    return r;
}
struct EpiUpConv {
    static constexpr bool PERM = true, AFTER_DRAIN = false;
    bf16_t* ACT; const float* ssq; const float* fw; const float* fb; float* bnd; PG8_LAS float* X;
    static constexpr int NUPc = 5632, DFFc = 2816;
    __device__ __forceinline__ void operator()(f32x4 (&acc)[2][2][4][2], const Unit& u, int wr, int wc, int fr_, int fq_) const {
        int fr = fr_, fq = fq_; asm volatile("" : "+v"(fr), "+v"(fq));
        const int row0 = u.pm * BM + wr * 64 + fr, cw = wc * 32 + 8 * fq;
#pragma unroll
        for (int ai = 0; ai < 2; ++ai)
#pragma unroll
            for (int m = 0; m < 4; ++m) { const int row = row0 + ai * HALF + m * 16;
                const f32x4 s = *(const f32x4*)(ssq + (size_t)row * 4); const float rs = 1.0f / sqrtf(((s[0] + s[1]) + (s[2] + s[3])) * (1.0f / 1024.0f) + 1e-6f);
#pragma unroll
                for (int bj = 0; bj < 2; ++bj)
#pragma unroll
                    for (int n = 0; n < 2; ++n) acc[ai][bj][m][n] = acc[ai][bj][m][n] * rs; }
        if (fr >= 14) {
#pragma unroll
            for (int ai = 0; ai < 2; ++ai)
#pragma unroll
                for (int bj = 0; bj < 2; ++bj)
#pragma unroll
                    for (int n = 0; n < 2; ++n) *(PG8_LAS f32x4*)(X + (((2 * ai + wr) * 2 + (fr - 14)) * 256 + bj * HALF + cw + 4 * n)) = acc[ai][bj][3][n];
        }
        { float* bt = bnd + (size_t)u.pm * 4 * NUPc + u.pn * 256;
          if (wr == 0 && fr < 2) {
#pragma unroll
              for (int bj = 0; bj < 2; ++bj)
#pragma unroll
                  for (int n = 0; n < 2; ++n) *(f32x4*)(bt + (size_t)fr * NUPc + bj * HALF + cw + 4 * n) = acc[0][bj][0][n]; }
          if (wr == 1 && fr >= 14) {
#pragma unroll
              for (int bj = 0; bj < 2; ++bj)
#pragma unroll
                  for (int n = 0; n < 2; ++n) *(f32x4*)(bt + (size_t)(2 + fr - 14) * NUPc + bj * HALF + cw + 4 * n) = acc[1][bj][3][n]; } }
        asm volatile("s_waitcnt lgkmcnt(0)" ::: "memory"); __builtin_amdgcn_s_barrier(); asm volatile("" ::: "memory");
        const int ch0 = u.pn * HALF + cw;
        unsigned pk[2][4][2][2];
#pragma unroll
        for (int n = 0; n < 2; ++n) {
            f32x4 w[2][3], b[2];
#pragma unroll
            for (int bj = 0; bj < 2; ++bj) { b[bj] = *(const f32x4*)(fb + bj * DFFc + ch0 + 4 * n);
#pragma unroll
                for (int k = 0; k < 3; ++k) w[bj][k] = *(const f32x4*)(fw + (size_t)k * NUPc + bj * DFFc + ch0 + 4 * n); }
#pragma unroll
            for (int ai = 0; ai < 2; ++ai) {
                const int g = 2 * ai + wr;
                f32x4 r1p[2], r2p[2];
#pragma unroll
                for (int bj = 0; bj < 2; ++bj) {
                    if (g > 0) { r2p[bj] = *(const PG8_LAS f32x4*)(X + (((g - 1) * 2 + (fr & 1)) * 256 + bj * HALF + cw + 4 * n)); r1p[bj] = *(const PG8_LAS f32x4*)(X + (((g - 1) * 2 + 1) * 256 + bj * HALF + cw + 4 * n)); }
                    else { r2p[bj] = (f32x4){0.f, 0.f, 0.f, 0.f}; r1p[bj] = (f32x4){0.f, 0.f, 0.f, 0.f}; } }
#pragma unroll
                for (int m = 0; m < 4; ++m) {
                    f32x4 o[2];
#pragma unroll
                    for (int bj = 0; bj < 2; ++bj) { const f32x4 cur = acc[ai][bj][m][n]; const f32x4 r1 = dpp4<0x121>(cur), r2 = dpp4<0x122>(cur);
                        const f32x4 p1 = fr == 0 ? r1p[bj] : r1, p2 = fr < 2 ? r2p[bj] : r2;
                        o[bj] = b[bj] + w[bj][0] * p2 + w[bj][1] * p1 + w[bj][2] * cur; r1p[bj] = r1; r2p[bj] = r2; }
                    f32x4 a;
#pragma unroll
                    for (int e = 0; e < 4; ++e) a[e] = o[0][e] * __builtin_amdgcn_rcpf(1.0f + __builtin_amdgcn_exp2f(o[0][e] * -1.4426950408889634f)) * o[1][e];
                    pk[ai][m][n][0] = cvt_pk_bf16(a[0], a[1]); pk[ai][m][n][1] = cvt_pk_bf16(a[2], a[3]);
                }
            }
        }
        {
            const int tid = (wr * 4 + wc) * 64 + fq * 16 + fr, rr = tid >> 4, chn = tid & 15;
            PG8_LAS unsigned char* sl = (PG8_LAS unsigned char*)(X + 2048);
            PG8_LAS unsigned char* wp = sl + (wr * 16 + fr) * 272 + wc * 64 + fq * 16;
            const PG8_LAS unsigned char* rp = sl + rr * 272 + chn * 16;
            bf16_t* gp = ACT + (size_t)(u.pm * BM + (rr >> 4) * 64 + (rr & 15)) * DFFc + u.pn * HALF + chn * 8;
#pragma unroll
            for (int ai = 0; ai < 2; ++ai)
#pragma unroll
                for (int m = 0; m < 4; ++m) { const int so = ((ai * 4 + m) & 1) * (32 * 272);
                    u32x4 wv; wv.x = pk[ai][m][0][0]; wv.y = pk[ai][m][0][1]; wv.z = pk[ai][m][1][0]; wv.w = pk[ai][m][1][1];
                    *(PG8_LAS u32x4*)(wp + so) = wv;
                    asm volatile("s_waitcnt lgkmcnt(0)" ::: "memory"); __builtin_amdgcn_s_barrier(); asm volatile("" ::: "memory");
                    *(u32x4*)(gp + (size_t)(ai * HALF + m * 16) * DFFc) = *(const PG8_LAS u32x4*)(rp + so); }
        }
    }
};
struct EpiNull {
    static constexpr bool PERM = false, AFTER_DRAIN = false;
    __device__ __forceinline__ void operator()(const f32x4 (&acc)[2][2][4][2], const Unit&, int, int, int, int) const {
#pragma unroll
        for (int ai = 0; ai < 2; ++ai)
#pragma unroll
            for (int bj = 0; bj < 2; ++bj)
#pragma unroll
                for (int m = 0; m < 4; ++m)
#pragma unroll
                    for (int n = 0; n < 2; ++n) asm volatile("" :: "v"(acc[ai][bj][m][n]));
    }
};
struct EpiNullP {
    static constexpr bool PERM = true, AFTER_DRAIN = false;
    __device__ __forceinline__ void operator()(const f32x4 (&acc)[2][2][4][2], const Unit&, int, int, int, int) const {
#pragma unroll
        for (int ai = 0; ai < 2; ++ai)
#pragma unroll
            for (int bj = 0; bj < 2; ++bj)
#pragma unroll
                for (int m = 0; m < 4; ++m)
#pragma unroll
                    for (int n = 0; n < 2; ++n) asm volatile("" :: "v"(acc[ai][bj][m][n]));
    }
};
struct EpiDummyContig {
    static constexpr bool PERM = true, AFTER_DRAIN = false;
    bf16_t* O; int npn;
    __device__ __forceinline__ void operator()(const f32x4 (&acc)[2][2][4][2], const Unit& u, int wr, int wc, int fr, int fq) const {
        bf16_t* base = O + (size_t)(u.pm * npn + u.pn) * 65536 + (wr * 4 + wc) * 8192 + (fq * 16 + fr) * 8;
#pragma unroll
        for (int ai = 0; ai < 2; ++ai)
#pragma unroll
            for (int m = 0; m < 4; ++m)
#pragma unroll
                for (int bj = 0; bj < 2; ++bj) { const f32x4 v0 = acc[ai][bj][m][0], v1 = acc[ai][bj][m][1];
                    u32x4 w; w.x = cvt_pk_bf16(v0[0], v0[1]); w.y = cvt_pk_bf16(v0[2], v0[3]); w.z = cvt_pk_bf16(v1[0], v1[1]); w.w = cvt_pk_bf16(v1[2], v1[3]);
                    *(u32x4*)(base + ((ai * 4 + m) * 2 + bj) * 512) = w; }
    }
};
template <class Epi, class Sched, bool ALIGN_EPI = false, bool SP2 = false>
__device__ __forceinline__ void gemm_phase(PG8_LAS unsigned char* lds, const Gemm g, const Sched& S, const Epi& E, const int wave_id  ) {
    int tid_ = wave_id * 64 + lane_id_fresh(); asm volatile("" : "+v"(tid_));
    const int tid = tid_, wid = __builtin_amdgcn_readfirstlane(tid >> 6), lane = tid & 63, wr = wid >> 2, wc = wid & 3, fr = lane & 15, fq = lane >> 4;
    const int K = g.K, nt = K / BK;
    unsigned voffA[2], voffB[2];
#pragma unroll
    for (int i = 0; i < 2; ++i) { int R, C; stage_rc(tid * 16 + i * 8192, R, C); const int Rb = Epi::PERM ? ((R & ~31) + perm32(R & 31)) : R;
        voffA[i] = (unsigned)(R * K + C) * 2u; voffB[i] = (unsigned)(Rb * K + C) * 2u; }
    const size_t kstep = (size_t)(BK * 2);
    const size_t hstep = (size_t)HALF * K * 2;
    const size_t tstep = 2 * hstep;
    const unsigned ldsw = (unsigned)wid * 1024u;
    const int aoff = lds_byte(wr * 64 + fr, fq * 8), boff = lds_byte(wc * 32 + fr, fq * 8);
#define PG8_SA(b, h) (((b) * 2 + (h)) * HTB)
#define PG8_SB(b, h) ((4 + (b) * 2 + (h)) * HTB)
#define PG8_STAGE(bufoff, gbase, voff) do { _Pragma("unroll") for (int _i = 0; _i < 2; ++_i) \
        __builtin_amdgcn_global_load_lds((const unsigned*)((const char*)(gbase) + (voff)[_i]), (PG8_LAS unsigned*)(lds + (bufoff) + ldsw + _i * 8192), 16, 0, 0); } while (0)
#define PG8_LDA(dst, b, h) do { _Pragma("unroll") for (int m = 0; m < 4; ++m) _Pragma("unroll") for (int k = 0; k < 2; ++k) dst[m][k] = *(const PG8_LAS bf16x8*)(lds + PG8_SA(b, h) + aoff + m * 2048 + k * 1024); } while (0)
#define PG8_LDB(dst, b, h) do { _Pragma("unroll") for (int n = 0; n < 2; ++n) _Pragma("unroll") for (int k = 0; k < 2; ++k) dst[n][k] = *(const PG8_LAS bf16x8*)(lds + PG8_SB(b, h) + boff + n * 2048 + k * 1024); } while (0)
#define PG8_MMA(ai, bj, At, Bt) do { __builtin_amdgcn_s_setprio(1); _Pragma("unroll") for (int m = 0; m < 4; ++m) _Pragma("unroll") for (int n = 0; n < 2; ++n) _Pragma("unroll") for (int k = 0; k < 2; ++k) \
        acc[ai][bj][m][n] = __builtin_amdgcn_mfma_f32_16x16x32_bf16(Bt[n][k], At[m][k], acc[ai][bj][m][n], 0, 0, 0); __builtin_amdgcn_s_setprio(0); } while (0)
#define PG8_WAIT_V(n) asm volatile("s_waitcnt vmcnt(" #n ")" ::: "memory")
#define PG8_WAIT_L(n) asm volatile("s_waitcnt lgkmcnt(" #n ")" ::: "memory")
#define PG8_BAR __builtin_amdgcn_s_barrier()
#define PG8_SCHED __builtin_amdgcn_sched_barrier(0)
    Unit cur, nxt; int ui = 0;
    if (!S.next(0, cur)) return;
    f32x4 acc[2][2][4][2];
#pragma unroll
    for (int a = 0; a < 2; ++a)
#pragma unroll
        for (int b = 0; b < 2; ++b)
#pragma unroll
            for (int m = 0; m < 4; ++m)
#pragma unroll
                for (int n = 0; n < 2; ++n) acc[a][b][m][n] = (f32x4){0.f, 0.f, 0.f, 0.f};
    bf16x8 At[4][2], B0[2][2], B1[2][2];
    const char* cA = (const char*)g.A + (size_t)cur.pm * tstep; const char* cB = (const char*)g.Bt + (size_t)cur.pn * tstep;
    S.a_ready(cur);
    if constexpr (SP2) {
        PG8_STAGE(PG8_SB(0, 0), cB, voffB); PG8_STAGE(PG8_SB(0, 1), cB + hstep, voffB); PG8_STAGE(PG8_SA(0, 0), cA, voffA); PG8_STAGE(PG8_SA(0, 1), cA + hstep, voffA);
        if (wr == 1) PG8_BAR;
        PG8_WAIT_V(2); PG8_BAR;
        PG8_STAGE(PG8_SB(1, 0), cB + kstep, voffB); PG8_STAGE(PG8_SA(1, 0), cA + kstep, voffA); PG8_STAGE(PG8_SB(1, 1), cB + hstep + kstep, voffB);
        PG8_WAIT_V(6); PG8_BAR;
    } else {
        PG8_STAGE(PG8_SB(0, 0), cB, voffB); PG8_STAGE(PG8_SA(0, 0), cA, voffA); PG8_STAGE(PG8_SB(0, 1), cB + hstep, voffB); PG8_STAGE(PG8_SA(0, 1), cA + hstep, voffA);
        if (wr == 1) PG8_BAR;
        PG8_WAIT_V(4); PG8_BAR;
        PG8_STAGE(PG8_SB(1, 0), cB + kstep, voffB); PG8_STAGE(PG8_SA(1, 0), cA + kstep, voffA); PG8_STAGE(PG8_SB(1, 1), cB + hstep + kstep, voffB);
        PG8_WAIT_V(6); PG8_BAR;
    }
    for (;;) {
        const bool has_next = S.next(ui + 1, nxt);
        const char* nA = has_next ? (const char*)g.A + (size_t)nxt.pm * tstep : cA; const char* nB = has_next ? (const char*)g.Bt + (size_t)nxt.pn * tstep : cB;
        for (int t = 0; t < nt; t += 2) {
            const bool last = (t == nt - 2);
            const char* a1 = cA + (size_t)(t + 1) * kstep;
            const char* a2 = last ? nA : cA + (size_t)(t + 2) * kstep; const char* b2 = last ? nB : cB + (size_t)(t + 2) * kstep;
            const char* a3 = a2 + kstep; const char* b3 = b2 + kstep;
            if (last && has_next) S.a_ready(nxt);
            if constexpr (SP2) {
            PG8_LDB(B0, 0, 0); PG8_LDB(B1, 0, 1); PG8_SCHED; PG8_LDA(At, 0, 0); PG8_STAGE(PG8_SA(1, 1), a1 + hstep, voffA);
            PG8_WAIT_V(8); PG8_WAIT_L(0); PG8_BAR; PG8_MMA(0, 0, At, B0); PG8_MMA(0, 1, At, B1); PG8_BAR; PG8_SCHED;
            PG8_LDA(At, 0, 1); PG8_STAGE(PG8_SB(0, 0), b2, voffB); PG8_STAGE(PG8_SB(0, 1), b2 + hstep, voffB); PG8_STAGE(PG8_SA(0, 0), a2, voffA);
            PG8_WAIT_V(8); PG8_WAIT_L(0); PG8_BAR; PG8_MMA(1, 0, At, B0); PG8_MMA(1, 1, At, B1); PG8_BAR; PG8_SCHED;
            PG8_LDB(B0, 1, 0); PG8_LDB(B1, 1, 1); PG8_SCHED; PG8_LDA(At, 1, 0); PG8_STAGE(PG8_SA(0, 1), a2 + hstep, voffA);
            PG8_WAIT_V(8); PG8_WAIT_L(0); PG8_BAR; PG8_MMA(0, 0, At, B0); PG8_MMA(0, 1, At, B1); PG8_BAR; PG8_SCHED;
            PG8_LDA(At, 1, 1); PG8_STAGE(PG8_SB(1, 0), b3, voffB); PG8_STAGE(PG8_SB(1, 1), b3 + hstep, voffB); PG8_STAGE(PG8_SA(1, 0), a3, voffA);
            PG8_WAIT_V(8); PG8_WAIT_L(0); PG8_BAR; PG8_MMA(1, 0, At, B0); PG8_MMA(1, 1, At, B1); PG8_BAR; PG8_SCHED;
            } else {
            PG8_LDB(B0, 0, 0); PG8_SCHED; PG8_LDA(At, 0, 0); PG8_STAGE(PG8_SA(1, 1), a1 + hstep, voffA);
            PG8_WAIT_L(8); PG8_BAR; PG8_WAIT_L(0); PG8_MMA(0, 0, At, B0); PG8_BAR; PG8_SCHED;
            PG8_LDB(B1, 0, 1); PG8_STAGE(PG8_SB(0, 0), b2, voffB);
            PG8_BAR; PG8_WAIT_L(0); PG8_MMA(0, 1, At, B1); PG8_BAR;
            PG8_LDA(At, 0, 1); PG8_STAGE(PG8_SA(0, 0), a2, voffA);
            PG8_BAR; PG8_WAIT_L(0); PG8_MMA(1, 0, At, B0); PG8_BAR; PG8_SCHED;
            PG8_STAGE(PG8_SB(0, 1), b2 + hstep, voffB);
            PG8_WAIT_V(6); PG8_BAR; PG8_MMA(1, 1, At, B1); PG8_BAR;
            PG8_LDB(B0, 1, 0); PG8_SCHED; PG8_LDA(At, 1, 0); PG8_STAGE(PG8_SA(0, 1), a2 + hstep, voffA);
            PG8_WAIT_L(8); PG8_BAR; PG8_WAIT_L(0); PG8_MMA(0, 0, At, B0); PG8_BAR; PG8_SCHED;
            PG8_LDB(B1, 1, 1); PG8_STAGE(PG8_SB(1, 0), b3, voffB);
            PG8_BAR; PG8_WAIT_L(0); PG8_MMA(0, 1, At, B1); PG8_BAR;
            PG8_LDA(At, 1, 1); PG8_STAGE(PG8_SA(1, 0), a3, voffA);
            PG8_BAR; PG8_WAIT_L(0); PG8_MMA(1, 0, At, B0); PG8_BAR; PG8_SCHED;
            PG8_STAGE(PG8_SB(1, 1), b3 + hstep, voffB);
            PG8_WAIT_V(6); PG8_BAR; PG8_MMA(1, 1, At, B1); PG8_BAR;
            }
        }
        if constexpr (ALIGN_EPI) { if (wr == 0) PG8_BAR; }
        if constexpr (!Epi::AFTER_DRAIN) { E(acc, cur, wr, wc, fr, fq); S.done(cur); }
        if (!has_next) break;
#pragma unroll
        for (int a = 0; a < 2; ++a)
#pragma unroll
            for (int b = 0; b < 2; ++b)
#pragma unroll
                for (int m = 0; m < 4; ++m)
#pragma unroll
                    for (int n = 0; n < 2; ++n) acc[a][b][m][n] = (f32x4){0.f, 0.f, 0.f, 0.f};
        cur = nxt; cA = nA; cB = nB; ++ui;
        if constexpr (ALIGN_EPI) { if (wr == 1) PG8_BAR; }
    }
    PG8_WAIT_V(0);
    if constexpr (!ALIGN_EPI) { if (wr == 0) PG8_BAR; }
    PG8_BAR;
    if constexpr (Epi::AFTER_DRAIN) { E.fused(acc, cur, wr, wc, fr, fq, lds, wid, lane); S.done(cur); }
#undef PG8_SA
#undef PG8_SB
#undef PG8_STAGE
#undef PG8_LDA
#undef PG8_LDB
#undef PG8_MMA
#undef PG8_WAIT_V
#undef PG8_WAIT_L
#undef PG8_BAR
#undef PG8_SCHED
}
}
#define GAS __attribute__((address_space(1)))
#define LAS __attribute__((address_space(3)))
typedef unsigned short bf16;
typedef unsigned v4u __attribute__((ext_vector_type(4)));
typedef float f32x4 __attribute__((ext_vector_type(4)));
typedef short bf16x8 __attribute__((ext_vector_type(8)));
typedef GAS unsigned gu32;
typedef GAS unsigned long long gu64;
#define RLX_AGENT __ATOMIC_RELAXED, __HIP_MEMORY_SCOPE_AGENT
#define LDS_WAIT() asm volatile("s_waitcnt lgkmcnt(0)" ::: "memory")
#define VM_WAIT() asm volatile("s_waitcnt vmcnt(0)" ::: "memory")
__device__ __forceinline__ unsigned long long rt() { return __builtin_amdgcn_s_memrealtime(); }
__device__ __forceinline__ unsigned f2bf(float f) { unsigned u = __builtin_bit_cast(unsigned, f); return (u + 0x7fffu + ((u >> 16) & 1u)) >> 16; }
__device__ __forceinline__ unsigned pk2(float lo, float hi) { return f2bf(lo) | (f2bf(hi) << 16); }

#define XB_TMO      128
#define XB_XCNT(j)  (256  + 64 * (j))
#define XB_XSUB(j)  (1280 + 64 * (j))
#define XB_XGEN(j)  (2304 + 64 * (j))
#define XB_TOP      3328
#define XB_TOPGEN   3392
#define XCD_BAR_WORDS 3456
#define XB_SPIN_CAP (1u << 18)

__device__ __forceinline__ unsigned xb_ld(unsigned* p)              { return __hip_atomic_load(p, __ATOMIC_RELAXED, __HIP_MEMORY_SCOPE_AGENT); }
__device__ __forceinline__ unsigned xb_add(unsigned* p, unsigned v) { return __hip_atomic_fetch_add(p, v, __ATOMIC_RELAXED, __HIP_MEMORY_SCOPE_AGENT); }
__device__ __forceinline__ unsigned xb_xcc_id() { return (unsigned)__builtin_amdgcn_s_getreg((3 << 11) | 20) & 0xFu; }
#define XB_SPIN(cond, bar) do { unsigned _sp = 0; while (cond) { __builtin_amdgcn_s_sleep(1); \
    if ((++_sp & 255u) == 0u) { if (xb_ld(&(bar)[XB_TMO])) break; if (_sp > XB_SPIN_CAP) { atomicAdd(&(bar)[XB_TMO], 1u); break; } } } } while (0)

struct XcdBarrier {
    unsigned* bar; unsigned x; int wave;
    volatile LAS unsigned* st;
};

__device__ __forceinline__ bool xb_thread0(int wave) { return wave == 0 && lane_id_fresh() == 0; }
__device__ __forceinline__ XcdBarrier xcd_barrier_post(unsigned* bar, volatile LAS unsigned* st, int wave) {
    XcdBarrier b; b.bar = bar; b.x = xb_xcc_id(); b.st = st; b.wave = wave;
    if (xb_thread0(wave)) (void)xb_add(&bar[XB_XCNT(b.x)], 1u);
    return b;
}
__device__ __forceinline__ void xcd_barrier_complete(unsigned* bar, unsigned x, unsigned& nloc, unsigned& nx) {
    const unsigned G = gridDim.x * gridDim.y * gridDim.z;
    unsigned sum, cnt, mine, sp = 0u;
    for (;;) {
        sum = 0u; cnt = 0u; mine = 0u;
#pragma unroll
        for (unsigned j = 0; j < 16; ++j) { const unsigned c = xb_ld(&bar[XB_XCNT(j)]); sum += c; cnt += (c > 0u) ? 1u : 0u; mine = (j == x) ? c : mine; }
        if (sum == G) break;
        __builtin_amdgcn_s_sleep(1);
        if ((++sp & 255u) == 0u) { if (xb_ld(&bar[XB_TMO])) break; if (sp > XB_SPIN_CAP) { atomicAdd(&bar[XB_TMO], 1u); break; } }
    }
    nloc = mine > 0u ? mine : 1u; nx = cnt > 0u ? cnt : 1u;
}

__device__ __forceinline__ void xcd_barrier(const XcdBarrier& b) {
    asm volatile("s_waitcnt vmcnt(0)" ::: "memory");
    __syncthreads();
    if (xb_thread0(b.wave)) {
        unsigned* bar = b.bar;
        __builtin_amdgcn_s_waitcnt(0);
        unsigned nloc = b.st[0], nx = b.st[1];
        if (nloc == 0u) { xcd_barrier_complete(bar, b.x, nloc, nx); b.st[0] = nloc; b.st[1] = nx; }
        const unsigned old = xb_add(&bar[XB_XSUB(b.x)], 1u);
        const unsigned gen = old / nloc;
        if (old + 1u == (gen + 1u) * nloc) {
            __builtin_amdgcn_fence(__ATOMIC_RELEASE, "agent");
            asm volatile("s_waitcnt vmcnt(0)" ::: "memory");
            const unsigned og = xb_add(&bar[XB_TOP], 1u);
            const unsigned tg = og / nx;
            if (og + 1u == (tg + 1u) * nx) xb_add(&bar[XB_TOPGEN], 1u);
            else XB_SPIN(xb_ld(&bar[XB_TOPGEN]) == tg, bar);
            __builtin_amdgcn_fence(__ATOMIC_ACQUIRE, "agent");
            xb_add(&bar[XB_XGEN(b.x)], 1u);
            asm volatile("s_waitcnt vmcnt(0)" ::: "memory");
        } else {
            XB_SPIN(xb_ld(&bar[XB_XGEN(b.x)]) == gen, bar);
            __builtin_amdgcn_fence(__ATOMIC_ACQUIRE, "agent");
            asm volatile("s_waitcnt vmcnt(0)" ::: "memory");
        }
    }
    __syncthreads();
}
constexpr int NWAVES = 8;
#ifndef MK_N_LAUNCHES
#define MK_N_LAUNCHES 1
#endif
constexpr int N_LAUNCHES = MK_N_LAUNCHES;
constexpr int N_PHASES = 6;
#ifndef PROBE_DUP
#define PROBE_DUP 0
#endif
#define DUP(k) (1 + ((PROBE_DUP >> (k)) & 1))
#ifndef PROBE_NULL
#define PROBE_NULL 0
#endif

constexpr int D = 1024, BATCH = 8, SEQ = 2048, M = BATCH * SEQ;
constexpr int CW = 512, HD = 64, NH = 8, NKV = 2, AW = 512, INW = 2304, DFF = 2816, NUP = 2 * DFF;
constexpr int C_GB = 0, C_GC = 512, C_HC = 1024, C_Q = 1536, C_K = 2048, C_V = 2176;
constexpr float EPS = 1e-6f;

constexpr size_t MiB = 1u << 20;
constexpr size_t WS_CTL = 0, CTL_ZERO_BYTES = 1 * MiB;
constexpr size_t WS_WIN = 2 * MiB;
constexpr size_t WS_WOUT = 7 * MiB;
constexpr size_t WS_WUP = 9 * MiB;
constexpr size_t WS_WDOWN = 20 * MiB;
constexpr size_t WS_SSQ = 26 * MiB;
constexpr size_t WS_XN = 32 * MiB;
constexpr size_t WS_PROJ = 64 * MiB;
constexpr size_t WS_Y = 136 * MiB;
constexpr size_t WS_BND = 26 * MiB + 512 * 1024;
constexpr size_t WS_ACT = 64 * MiB;
constexpr size_t WS_END = 168 * MiB;
constexpr int CW_TMO = 0, CW_CODE = 1;
constexpr int CW_BAR = 4096;
constexpr int CW_CEN = 8192;
constexpr int CW_LBAR = 10240;
constexpr int CW_WDONE = 12288;
constexpr int CW_WARR = 12352;

constexpr int LDS_BYTES = 163840;
constexpr int RING_OFF = 0, RING_BYTES = 131072;
constexpr int SCR_OFF = RING_BYTES;
constexpr int LDSCTL_OFF = LDS_BYTES - 1024, MISC_OFF = LDSCTL_OFF + 320;
constexpr int P2_KP = 72, P2_VP = 196, P2_SP = 520;
constexpr int P2_K_OFF = 0, P2_V_OFF = P2_K_OFF + 2 * 192 * P2_KP * 2, P2_STG_OFF = P2_V_OFF + 128 * P2_VP * 2, P2_TAB_OFF = P2_STG_OFF + 32 * P2_SP * 2;
constexpr int P2_LINV_OFF = P2_TAB_OFF + 8 * 192 * 4, P2_END = P2_LINV_OFF + 8 * 32 * 4;
static_assert(SCR_OFF + 8192 + 2 * 32 * 272 <= LDSCTL_OFF && SCR_OFF + 32 * 528 <= LDSCTL_OFF && P2_END <= LDSCTL_OFF && (P2_V_OFF % 16) == 0 && (P2_STG_OFF % 16) == 0 && (P2_TAB_OFF % 16) == 0, "LDS map");

__device__ __forceinline__ float bf2f(unsigned short h) { return __builtin_bit_cast(float, (unsigned)h << 16); }
__device__ __forceinline__ float wave_sum(float v) {
#pragma unroll
    for (int o = 1; o < 64; o <<= 1) v += __shfl_xor(v, o);
    return v;
}
__device__ __forceinline__ float wave_max(float v) {
#pragma unroll
    for (int o = 1; o < 64; o <<= 1) v = fmaxf(v, __shfl_xor(v, o));
    return v;
}
__host__ __device__ __forceinline__ int up_src_col(int np) { const int pn = np >> 8, w = np & 255, bj = w >> 7, c = w & 127; return bj * DFF + pn * 128 + c; }
__device__ __forceinline__ int t5_bucket(int d) {
    if (d < 16) return d;
    const int b = 16 + (int)(logf((float)d / 16.f) / 2.0794415416798357f * 16.f);
    return b < 31 ? b : 31;
}

constexpr int P0_TP = 65, P0_SCR_BYTES = 64 * P0_TP * 4;
template <int MODE>
__device__ __forceinline__ void p0_transpose_item(const float* W, const float* scale, int K, int N, bf16* WT, LAS float* scr, int item, int lane) {
    const int nblk = N / 64, kb = item / nblk, nb = item % nblk, k0 = 64 * kb, n0 = 64 * nb;
    const int srcn = (MODE == 1 ? up_src_col(n0) : n0) + 4 * (lane & 15), kr = lane >> 4;
    f32x4 v[16];
#pragma unroll
    for (int i = 0; i < 16; ++i) v[i] = *(const GAS f32x4*)(W + (size_t)(k0 + 4 * i + kr) * N + srcn);
#pragma unroll
    for (int i = 0; i < 16; ++i) { const int kk = 4 * i + kr; f32x4 t = v[i]; if (scale) t = t * scale[k0 + kk]; LAS float* d = scr + kk * P0_TP + 4 * (lane & 15); d[0] = t[0]; d[1] = t[1]; d[2] = t[2]; d[3] = t[3]; }
    LDS_WAIT(); asm volatile("" ::: "memory");
    const int c = lane & 7;
#pragma unroll
    for (int j = 0; j < 8; ++j) { const int n = (lane >> 3) + 8 * j; const LAS float* sp = scr + (8 * c) * P0_TP + n;
        v4u o; o.x = pk2(sp[0 * P0_TP], sp[1 * P0_TP]); o.y = pk2(sp[2 * P0_TP], sp[3 * P0_TP]); o.z = pk2(sp[4 * P0_TP], sp[5 * P0_TP]); o.w = pk2(sp[6 * P0_TP], sp[7 * P0_TP]);
        *(GAS v4u*)(WT + (size_t)(n0 + n) * K + k0 + 8 * c) = o; }
    LDS_WAIT(); asm volatile("" ::: "memory");
}
__device__ __forceinline__ void rms_rows2_to_bf16(const float* xrow, bf16* orow, int lane) {
    const GAS f32x4* xr = (const GAS f32x4*)xrow + lane;
    f32x4 v[2][4]; float s[2] = {0.f, 0.f};
#pragma unroll
    for (int r = 0; r < 2; ++r)
#pragma unroll
        for (int j = 0; j < 4; ++j) v[r][j] = xr[r * (D / 4) + 64 * j];
#pragma unroll
    for (int r = 0; r < 2; ++r)
#pragma unroll
        for (int j = 0; j < 4; ++j) s[r] += (v[r][j].x * v[r][j].x + v[r][j].y * v[r][j].y) + (v[r][j].z * v[r][j].z + v[r][j].w * v[r][j].w);
#pragma unroll
    for (int r = 0; r < 2; ++r) {
        const float rstd = 1.f / sqrtf(wave_sum(s[r]) * (1.f / D) + EPS);
        GAS unsigned long long* o8 = (GAS unsigned long long*)(orow + (size_t)r * D) + lane;
#pragma unroll
        for (int j = 0; j < 4; ++j) o8[64 * j] = (unsigned long long)pk2(v[r][j].x * rstd, v[r][j].y * rstd) | ((unsigned long long)pk2(v[r][j].z * rstd, v[r][j].w * rstd) << 32);
    }
}

struct Args { const float* in[16]; float* out; unsigned char* ws; int ph_lo, ph_hi, li, pad; };

constexpr float LOG2E = 1.4426950408889634f;
typedef float f32x16 __attribute__((ext_vector_type(16)));
typedef unsigned u32x2 __attribute__((ext_vector_type(2)));
__device__ __forceinline__ int crow(int r, int hi) { return (r & 3) + 8 * (r >> 2) + 4 * hi; }
__device__ __forceinline__ void unpack8(const v4u w, float (&f)[8]) {
    f[0] = __builtin_bit_cast(float, w.x << 16); f[1] = __builtin_bit_cast(float, w.x & 0xffff0000u); f[2] = __builtin_bit_cast(float, w.y << 16); f[3] = __builtin_bit_cast(float, w.y & 0xffff0000u);
    f[4] = __builtin_bit_cast(float, w.z << 16); f[5] = __builtin_bit_cast(float, w.z & 0xffff0000u); f[6] = __builtin_bit_cast(float, w.w << 16); f[7] = __builtin_bit_cast(float, w.w & 0xffff0000u);
}
__device__ __forceinline__ v4u pack8(const float (&f)[8]) { v4u w; w.x = pg8::cvt_pk_bf16(f[0], f[1]); w.y = pg8::cvt_pk_bf16(f[2], f[3]); w.z = pg8::cvt_pk_bf16(f[4], f[5]); w.w = pg8::cvt_pk_bf16(f[6], f[7]); return w; }

__device__ __forceinline__ void p2_table(const Args& args, LAS unsigned char* lds, int tid) {
    LAS float* rtab = (LAS float*)(lds + P2_TAB_OFF); const float* rel = args.in[6];
    for (int e = tid; e < 8 * 192; e += NWAVES * 64) { const int h = e / 192, i = e % 192, d = 159 - i; rtab[e] = (d >= 0 && d <= 127) ? rel[t5_bucket(d) * NH + h] * LOG2E : -1e30f; }
}
__device__ __forceinline__ void p2_unit(const Args& args, LAS unsigned char* lds, int unit, int tid_in, int wave) {
    const bf16* PROJ = (const bf16*)(args.ws + WS_PROJ); bf16* Y = (bf16*)(args.ws + WS_Y);
    const float* conv_w = args.in[3]; const float* qg = args.in[4]; const float* kg = args.in[5]; const float* sinks = args.in[7];
    const float* gconv = args.in[8]; const float* gattn = args.in[9];
    const int t0 = unit * 64, s0 = t0 & (SEQ - 1);
    {
        int lane = tid_in & 63; asm volatile("" : "+v"(lane));
        const int c0 = 8 * lane, tb = t0 + 8 * wave;
        float w0[8], w1[8], w2[8], p2[8], p1[8], y[8][8], ssq[8];
        { const f32x4* cw = (const f32x4*)(conv_w + c0); const f32x4 a0 = cw[0], a1 = cw[1], b0 = cw[CW / 4], b1 = cw[CW / 4 + 1], c0v = cw[2 * CW / 4], c1v = cw[2 * CW / 4 + 1];
#pragma unroll
          for (int k = 0; k < 4; ++k) { w0[k] = a0[k]; w0[4 + k] = a1[k]; w1[k] = b0[k]; w1[4 + k] = b1[k]; w2[k] = c0v[k]; w2[4 + k] = c1v[k]; } }
        v4u rg[10], rh[10], rb[8];
        const bool halo = !(s0 == 0 && wave == 0);
#pragma unroll
        for (int i = 0; i < 10; ++i) { const bf16* r = PROJ + (size_t)(tb - 2 + i) * INW + c0;
            if (i >= 2 || halo) { rg[i] = *(const v4u*)(r + C_GC); rh[i] = *(const v4u*)(r + C_HC); } else { rg[i] = (v4u){0u, 0u, 0u, 0u}; rh[i] = (v4u){0u, 0u, 0u, 0u}; }
            if (i >= 2) rb[i - 2] = *(const v4u*)(r + C_GB); }
        { float a[8], b[8]; unpack8(rg[0], a); unpack8(rh[0], b);
#pragma unroll
          for (int k = 0; k < 8; ++k) p2[k] = a[k] * b[k];
          unpack8(rg[1], a); unpack8(rh[1], b);
#pragma unroll
          for (int k = 0; k < 8; ++k) p1[k] = a[k] * b[k]; }
#pragma unroll
        for (int i = 0; i < 8; ++i) {
            float a[8], b[8], g[8]; unpack8(rg[i + 2], a); unpack8(rh[i + 2], b); unpack8(rb[i], g);
            float ss = 0.f;
#pragma unroll
            for (int k = 0; k < 8; ++k) { const float p0 = a[k] * b[k]; const float v = g[k] * (w0[k] * p2[k] + w1[k] * p1[k] + w2[k] * p0); y[i][k] = v; ss += v * v; p2[k] = p1[k]; p1[k] = p0; }
            ssq[i] = wave_sum(ss);
        }
        float gc[8]; { const f32x4* gp = (const f32x4*)(gconv + c0); const f32x4 a0 = gp[0], a1 = gp[1];
#pragma unroll
          for (int k = 0; k < 4; ++k) { gc[k] = a0[k]; gc[4 + k] = a1[k]; } }
#pragma unroll
        for (int i = 0; i < 8; ++i) {
            const float rs = 1.0f / sqrtf(ssq[i] * (1.f / CW) + EPS); float o[8];
#pragma unroll
            for (int k = 0; k < 8; ++k) o[k] = y[i][k] * rs * gc[k];
            *(GAS v4u*)(Y + (size_t)(tb + i) * D + c0) = pack8(o);
        }
    }
    {
        int tid = tid_in, lane = tid_in & 63; asm volatile("" : "+v"(tid), "+v"(lane));
        v4u kraw[6], vraw[6];
#pragma unroll
        for (int it = 0; it < 6; ++it) {
            const int c = it * 512 + tid, ch8 = c & 7, kr = c >> 3, key = kr % 192, kvh = kr / 192;
            kraw[it] = (v4u){0u, 0u, 0u, 0u};
            if (s0 - 128 + key >= 0) kraw[it] = *(const v4u*)(PROJ + (size_t)(t0 - 128 + key) * INW + C_K + kvh * HD + ch8 * 8);
        }
#pragma unroll
        for (int it = 0; it < 6; ++it) {
            const int item = it * 8 + wave, kvh = item / 24, rem = item % 24, ch8 = rem / 3, key = (rem % 3) * 64 + lane;
            vraw[it] = (v4u){0u, 0u, 0u, 0u};
            if (s0 - 128 + key >= 0) vraw[it] = *(const v4u*)(PROJ + (size_t)(t0 - 128 + key) * INW + C_V + kvh * HD + ch8 * 8);
        }
#pragma unroll
        for (int it = 0; it < 6; ++it) {
            const int c = it * 512 + tid, ch8 = c & 7, kr = c >> 3, key = kr % 192, kvh = kr / 192;
            float f[8]; unpack8(kraw[it], f);
            float ss = 0.f;
#pragma unroll
            for (int k = 0; k < 8; ++k) ss += f[k] * f[k];
            ss += __shfl_xor(ss, 1); ss += __shfl_xor(ss, 2); ss += __shfl_xor(ss, 4);
            const float rs = 1.0f / sqrtf(ss * (1.f / HD) + EPS);
            const f32x4* kgp = (const f32x4*)(kg + ch8 * 8); const f32x4 g0 = kgp[0], g1 = kgp[1];
#pragma unroll
            for (int k = 0; k < 4; ++k) { f[k] *= rs * g0[k]; f[4 + k] *= rs * g1[k]; }
            *(LAS v4u*)(lds + P2_K_OFF + ((kvh * 192 + key) * P2_KP + ch8 * 8) * 2) = pack8(f);
        }
#pragma unroll
        for (int it = 0; it < 6; ++it) {
            const int item = it * 8 + wave, kvh = item / 24, rem = item % 24, ch8 = rem / 3, key = (rem % 3) * 64 + lane;
            const v4u raw = vraw[it];
            LAS unsigned short* vt = (LAS unsigned short*)(lds + P2_V_OFF) + (kvh * HD + ch8 * 8) * P2_VP + key;
            vt[0 * P2_VP] = (unsigned short)(raw.x & 0xffffu); vt[1 * P2_VP] = (unsigned short)(raw.x >> 16); vt[2 * P2_VP] = (unsigned short)(raw.y & 0xffffu); vt[3 * P2_VP] = (unsigned short)(raw.y >> 16);
            vt[4 * P2_VP] = (unsigned short)(raw.z & 0xffffu); vt[5 * P2_VP] = (unsigned short)(raw.z >> 16); vt[6 * P2_VP] = (unsigned short)(raw.w & 0xffffu); vt[7 * P2_VP] = (unsigned short)(raw.w >> 16);
        }
    }
    __syncthreads();
    int lane = tid_in & 63; asm volatile("" : "+v"(lane));
    const int h = wave, kvh = h >> 2, l31 = lane & 31, hh = lane >> 5;
    const float sink2 = sinks[h] * LOG2E;
    const LAS float* rtab = (const LAS float*)(lds + P2_TAB_OFF) + h * 192;
    LAS float* linv = (LAS float*)(lds + P2_LINV_OFF) + wave * 32;
    v4u qraw[4];
    { const bf16* qp = PROJ + (size_t)(t0 + l31) * INW + C_Q + h * HD + 8 * hh;
#pragma unroll
      for (int s = 0; s < 4; ++s) qraw[s] = *(const v4u*)(qp + 16 * s); }
#pragma unroll 1
    for (int qb = 0; qb < 2; ++qb) {
        int jlo = (128 - s0 - 32 * qb + 31) >> 5; jlo = jlo < 0 ? 0 : jlo;
        bf16x8 qf[4];
        {
            float f[4][8]; float ss = 0.f;
#pragma unroll
            for (int s = 0; s < 4; ++s) { unpack8(qraw[s], f[s]);
#pragma unroll
                for (int k = 0; k < 8; ++k) ss += f[s][k] * f[s][k]; }
            ss += __shfl_xor(ss, 32);
            const float qs = (1.0f / sqrtf(ss * (1.f / HD) + EPS)) * (0.125f * LOG2E);
#pragma unroll
            for (int s = 0; s < 4; ++s) { const f32x4* gp = (const f32x4*)(qg + 16 * s + 8 * hh); const f32x4 g0 = gp[0], g1 = gp[1];
#pragma unroll
                for (int k = 0; k < 4; ++k) { f[s][k] *= qs * g0[k]; f[s][4 + k] *= qs * g1[k]; }
                qf[s] = __builtin_bit_cast(bf16x8, pack8(f[s])); }
            if (qb == 0) {
                const bf16* qp = PROJ + (size_t)(t0 + 32 + l31) * INW + C_Q + h * HD + 8 * hh;
#pragma unroll
                for (int s = 0; s < 4; ++s) qraw[s] = *(const v4u*)(qp + 16 * s);
            }
        }
        f32x16 P[5];
#pragma unroll
        for (int j = 0; j < 5; ++j) {
            if (j >= jlo) {
                const LAS float* tb = rtab + (31 + 32 * j - l31 + 4 * hh);
#pragma unroll
                for (int r = 0; r < 16; ++r) P[j][r] = tb[(r & 3) + 8 * (r >> 2)];
                const LAS unsigned char* kp = lds + P2_K_OFF + ((kvh * 192 + 32 * (qb + j) + l31) * P2_KP + 8 * hh) * 2;
#pragma unroll
                for (int s = 0; s < 4; ++s) P[j] = __builtin_amdgcn_mfma_f32_32x32x16_bf16(*(const LAS bf16x8*)(kp + 32 * s), qf[s], P[j], 0, 0, 0);
            } else {
#pragma unroll
                for (int r = 0; r < 16; ++r) P[j][r] = -1e30f;
            }
        }
        float mx = sink2;
#pragma unroll
        for (int j = 0; j < 5; ++j)
#pragma unroll
            for (int r = 0; r < 16; ++r) mx = fmaxf(mx, P[j][r]);
        mx = fmaxf(mx, __shfl_xor(mx, 32));
        float sum = 0.f;
#pragma unroll
        for (int j = 0; j < 5; ++j)
#pragma unroll
            for (int r = 0; r < 16; ++r) { const float e = __builtin_amdgcn_exp2f(P[j][r] - mx); P[j][r] = e; sum += e; }
        sum += __shfl_xor(sum, 32); sum += __builtin_amdgcn_exp2f(sink2 - mx);
        if (hh == 0) linv[l31] = 1.0f / sum;
        f32x16 o[2];
#pragma unroll
        for (int r = 0; r < 16; ++r) { o[0][r] = 0.f; o[1][r] = 0.f; }
#pragma unroll
        for (int j = 0; j < 5; ++j) {
            if (j >= jlo) {
#pragma unroll
                for (int s = 0; s < 2; ++s) {
                    v4u pw; pw.x = pg8::cvt_pk_bf16(P[j][8 * s + 0], P[j][8 * s + 1]); pw.y = pg8::cvt_pk_bf16(P[j][8 * s + 2], P[j][8 * s + 3]);
                    pw.z = pg8::cvt_pk_bf16(P[j][8 * s + 4], P[j][8 * s + 5]); pw.w = pg8::cvt_pk_bf16(P[j][8 * s + 6], P[j][8 * s + 7]);
                    const bf16x8 pa = __builtin_bit_cast(bf16x8, pw);
#pragma unroll
                    for (int db = 0; db < 2; ++db) {
                        const LAS unsigned char* vp = lds + P2_V_OFF + ((kvh * HD + 32 * db + l31) * P2_VP + 32 * (qb + j) + 16 * s + 4 * hh) * 2;
                        const u32x2 lo = *(const LAS u32x2*)vp, hi = *(const LAS u32x2*)(vp + 16);
                        v4u vw; vw.x = lo.x; vw.y = lo.y; vw.z = hi.x; vw.w = hi.y;
                        o[db] = __builtin_amdgcn_mfma_f32_32x32x16_bf16(pa, __builtin_bit_cast(bf16x8, vw), o[db], 0, 0, 0);
                    }
                }
            }
        }
        {
            LAS unsigned short* stg = (LAS unsigned short*)(lds + P2_STG_OFF) + h * HD + l31;
#pragma unroll
            for (int r = 0; r < 16; ++r) { const int tk = crow(r, hh); const float li = linv[tk];
                stg[tk * P2_SP] = (unsigned short)f2bf(o[0][r] * li); stg[tk * P2_SP + 32] = (unsigned short)f2bf(o[1][r] * li); }
        }
        __syncthreads();
        {
            float ga[8]; { const f32x4* gp = (const f32x4*)(gattn + 8 * lane); const f32x4 a0 = gp[0], a1 = gp[1];
#pragma unroll
              for (int k = 0; k < 4; ++k) { ga[k] = a0[k]; ga[4 + k] = a1[k]; } }
#pragma unroll
            for (int i = 0; i < 4; ++i) {
                const int tk = 4 * wave + i; float f[8]; unpack8(*(const LAS v4u*)(lds + P2_STG_OFF + (tk * P2_SP + 8 * lane) * 2), f);
                float ss = 0.f;
#pragma unroll
                for (int k = 0; k < 8; ++k) ss += f[k] * f[k];
                const float rs = 1.0f / sqrtf(wave_sum(ss) * (1.f / AW) + EPS);
#pragma unroll
                for (int k = 0; k < 8; ++k) f[k] *= rs * ga[k];
                *(GAS v4u*)(Y + (size_t)(t0 + 32 * qb + tk) * D + CW + 8 * lane) = pack8(f);
            }
        }
        __syncthreads();
    }
}

__device__ __forceinline__ void fixup_rows(const Args& args, int pm, int tid) {
    const float* bnd = (const float*)(args.ws + WS_BND); bf16* ACT = (bf16*)(args.ws + WS_ACT);
    const float* fw = args.in[13]; const float* fb = args.in[14];
    const float* prev = bnd + (size_t)(pm - 1) * 4 * NUP; const float* cur = bnd + (size_t)pm * 4 * NUP;
    for (int item = tid; item < 2 * (DFF / 8); item += NWAVES * 64) {
        const int rsel = item / (DFF / 8), ch0 = (item % (DFF / 8)) * 8, col = (ch0 >> 7) * 256 + (ch0 & 127);
        const float* x2 = prev + (size_t)(2 + rsel) * NUP + col; const float* x1 = (rsel == 0 ? prev + (size_t)3 * NUP : cur) + col; const float* x0 = cur + (size_t)rsel * NUP + col;
        unsigned pk[4];
#pragma unroll
        for (int q = 0; q < 2; ++q) {
            f32x4 o[2];
#pragma unroll
            for (int bj = 0; bj < 2; ++bj) {
                const f32x4 a2 = *(const f32x4*)(x2 + bj * 128 + 4 * q), a1 = *(const f32x4*)(x1 + bj * 128 + 4 * q), a0 = *(const f32x4*)(x0 + bj * 128 + 4 * q);
                const float* wp = fw + bj * DFF + ch0 + 4 * q;
                o[bj] = *(const f32x4*)(fb + bj * DFF + ch0 + 4 * q) + *(const f32x4*)(wp) * a2 + *(const f32x4*)(wp + NUP) * a1 + *(const f32x4*)(wp + 2 * NUP) * a0;
            }
            float a[4];
#pragma unroll
            for (int e = 0; e < 4; ++e) a[e] = o[0][e] * __builtin_amdgcn_rcpf(1.0f + __builtin_amdgcn_exp2f(o[0][e] * -1.4426950408889634f)) * o[1][e];
            pk[2 * q] = pk2(a[0], a[1]); pk[2 * q + 1] = pk2(a[2], a[3]);
        }
        v4u wv; wv.x = pk[0]; wv.y = pk[1]; wv.z = pk[2]; wv.w = pk[3];
        *(GAS v4u*)(ACT + (size_t)(pm * 256 + rsel) * DFF + ch0) = wv;
    }
}

__device__ __forceinline__ void xcd_local_barrier(unsigned* cnt, unsigned target, unsigned* tmo, int wave, unsigned* flag = nullptr, unsigned need = 0u) {
    asm volatile("s_waitcnt vmcnt(0)" ::: "memory");
    __syncthreads();
    if (xb_thread0(wave)) {
        __builtin_amdgcn_s_waitcnt(0);
        (void)xb_add(cnt, 1u);
        unsigned sp = 0u;
        while (xb_ld(cnt) < target) { __builtin_amdgcn_s_sleep(1); if ((++sp & 255u) == 0u) { if (xb_ld(tmo)) break; if (sp > XB_SPIN_CAP) { atomicAdd(tmo, 1u); break; } } }
        if (flag) { sp = 0u; while (xb_ld(flag) < need) { __builtin_amdgcn_s_sleep(1); if ((++sp & 255u) == 0u) { if (xb_ld(tmo)) break; if (sp > XB_SPIN_CAP) { atomicAdd(tmo, 1u); break; } } } }
        __builtin_amdgcn_fence(__ATOMIC_ACQUIRE, "agent");
        asm volatile("s_waitcnt vmcnt(0)" ::: "memory");
    }
    __syncthreads();
}

__global__ void __launch_bounds__(NWAVES * 64, 2) mk_fwd(Args args) {
    extern __shared__ __attribute__((aligned(16))) unsigned char lds_raw[];
    LAS unsigned char* lds = (LAS unsigned char*)lds_raw;
    volatile LAS unsigned* MISC = (volatile LAS unsigned*)(lds + MISC_OFF);
    const int wave = __builtin_amdgcn_readfirstlane(threadIdx.x >> 6);
#define FRESH_TID(t) int t = wave * 64 + lane_id_fresh(); asm volatile("" : "+v"(t))
    FRESH_TID(tid); const int lane = tid & 63;
    const int G = gridDim.x; const int bx0 = blockIdx.x;
    unsigned char* ws = args.ws;
    gu32* ctl = (gu32*)(ws + WS_CTL);
    bf16* Win_t = (bf16*)(ws + WS_WIN); bf16* Wout_t = (bf16*)(ws + WS_WOUT); bf16* Wup_t = (bf16*)(ws + WS_WUP); bf16* Wdown_t = (bf16*)(ws + WS_WDOWN);
    float* SSQ = (float*)(ws + WS_SSQ); bf16* XN = (bf16*)(ws + WS_XN); bf16* PROJ = (bf16*)(ws + WS_PROJ); bf16* Y = (bf16*)(ws + WS_Y);
    bf16* ACT = (bf16*)(ws + WS_ACT);
    for (int u = tid; u < (LDS_BYTES - LDSCTL_OFF) / 4; u += NWAVES * 64) ((LAS unsigned*)(lds + LDSCTL_OFF))[u] = 0u;
    __syncthreads();
    XcdBarrier bar; bar.bar = (unsigned*)(ctl + CW_BAR); bar.x = 0; bar.st = nullptr; bar.wave = wave;
    if (N_LAUNCHES == 1) bar = xcd_barrier_post((unsigned*)(ctl + CW_BAR), MISC + 8, wave);
    const unsigned xcc = xb_xcc_id();
    if (N_LAUNCHES == 1) { if (xb_thread0(wave)) MISC[10] = xb_add((unsigned*)(ctl + CW_CEN) + 64 * xcc, 1u); __syncthreads(); }
    const unsigned rank = MISC[10];
    int bx = bx0, vcu = (G % 8 == 0) ? (bx0 % 8) * (G / 8) + bx0 / 8 : bx0; bool regular = false; unsigned nlb = 0u;
#define LOCAL_BAR() do { if (N_LAUNCHES == 1) { if (regular) { ++nlb; xcd_local_barrier((unsigned*)(ctl + CW_LBAR) + 64 * xcc, nlb * (unsigned)(G / 8), (unsigned*)(ctl + CW_BAR) + XB_TMO, wave); } else xcd_barrier(bar); } } while (0)
#ifndef PROBE_XBAR
#define PROBE_XBAR 0
#endif
#define GRID_BAR() do { if (N_LAUNCHES == 1) { xcd_barrier(bar); for (int xb_ = 0; xb_ < PROBE_XBAR; ++xb_) xcd_barrier(bar); } } while (0)
    const int lo = args.ph_lo, hi = args.ph_hi;
#define IN(k) (lo <= (k) && (k) < hi)
#define BOTH(k) (IN(k) && IN((k) + 1))

    if (IN(0)) {
#pragma unroll 1
      for (int rep = 0; rep < DUP(0); ++rep) {
        LAS float* scr = (LAS float*)(lds + wave * P0_SCR_BYTES);
        const int gw = vcu * NWAVES + wave, NGW = G * NWAVES;
        constexpr int I_IN = (D / 64) * (INW / 64), I_OUT = (D / 64) * (D / 64);
        for (int it = gw; it < I_IN + I_OUT + M / 2; it += NGW) {
            int r = it;
            if (r < I_IN) { p0_transpose_item<0>(args.in[2], args.in[1], D, INW, Win_t, scr, r, lane); continue; } r -= I_IN;
            if (r < I_OUT) { p0_transpose_item<0>(args.in[10], nullptr, D, D, Wout_t, scr, r, lane); continue; } r -= I_OUT;
            rms_rows2_to_bf16(args.in[0] + (size_t)(2 * r) * D, XN + (size_t)(2 * r) * D, lane);
        }
        if (DUP(0) > 1) __syncthreads();
      }
        if (BOTH(0)) GRID_BAR();
    }
    if (N_LAUNCHES == 1 && (G % 8) == 0) {
        bool reg = xcc < 8u;
#pragma unroll
        for (int j = 0; j < 8; ++j) reg = reg && (xb_ld((unsigned*)(ctl + CW_CEN) + 64 * j) == (unsigned)(G / 8));
        regular = __builtin_amdgcn_readfirstlane(reg ? 1 : 0) != 0;
        if (regular) { bx = (int)(rank * 8u + xcc); vcu = (bx % 8) * (G / 8) + bx / 8; }
    }
    if (IN(1)) {
        pg8::Gemm g{XN, Win_t, M, INW, D}; pg8::StaticOrder S; S.init(M, INW, G, bx);
        pg8::EpiBf16P E{PROJ, INW, lds + SCR_OFF};
        if ((PROBE_NULL >> 8) & 1) { pg8::EpiDummyContig Ed{(bf16*)(ws + WS_Y), INW / 256}; pg8::gemm_phase<pg8::EpiDummyContig, pg8::StaticOrder, true, true>(lds + RING_OFF, g, S, Ed, wave); __syncthreads(); }
        if ((PROBE_NULL >> 1) & 1) { pg8::EpiNullP En{}; pg8::gemm_phase<pg8::EpiNullP, pg8::StaticOrder, true, true>(lds + RING_OFF, g, S, En, wave); __syncthreads(); }
#pragma unroll 1
        for (int rep = 0; rep < DUP(1); ++rep) { pg8::gemm_phase<pg8::EpiBf16P, pg8::StaticOrder, true, true>(lds + RING_OFF, g, S, E, wave); if (DUP(1) > 1) __syncthreads(); }
        {
            const int nwg = (M / 256) * (INW / 256), nfull = nwg % G;
            if (nfull != 0 && bx >= nfull) {
                FRESH_TID(tq); const int lq = tq & 63;
                LAS float* scr = (LAS float*)(lds + wave * P0_SCR_BYTES);
                constexpr int I_UP = (D / 64) * (NUP / 64), I_DN = (DFF / 64) * (D / 64);
                const int gw = (bx - nfull) * NWAVES + wave, NGW = (G - nfull) * NWAVES;
                for (int it = gw; it < I_UP + I_DN; it += NGW) {
                    if (it < I_UP) p0_transpose_item<1>(args.in[12], args.in[11], D, NUP, Wup_t, scr, it, lq);
                    else p0_transpose_item<0>(args.in[15], nullptr, DFF, D, Wdown_t, scr, it - I_UP, lq);
                }
                asm volatile("s_waitcnt vmcnt(0)" ::: "memory"); __syncthreads();
                if (xb_thread0(wave)) {
                    const unsigned nprod = (unsigned)((G - nfull) / 8);
                    if (xb_add((unsigned*)(ctl + CW_WARR) + 64 * xcc, 1u) + 1u == nprod) { __builtin_amdgcn_fence(__ATOMIC_RELEASE, "agent"); asm volatile("s_waitcnt vmcnt(0)" ::: "memory"); (void)xb_add((unsigned*)(ctl + CW_WDONE), 1u); } }
            } else if (nfull == 0) {
                FRESH_TID(tq); const int lq = tq & 63;
                LAS float* scr = (LAS float*)(lds + wave * P0_SCR_BYTES);
                constexpr int I_UP = (D / 64) * (NUP / 64), I_DN = (DFF / 64) * (D / 64);
                for (int it = bx * NWAVES + wave; it < I_UP + I_DN; it += G * NWAVES) {
                    if (it < I_UP) p0_transpose_item<1>(args.in[12], args.in[11], D, NUP, Wup_t, scr, it, lq);
                    else p0_transpose_item<0>(args.in[15], nullptr, DFF, D, Wdown_t, scr, it - I_UP, lq);
                }
                asm volatile("s_waitcnt vmcnt(0)" ::: "memory"); __syncthreads();
                if (xb_thread0(wave)) { const unsigned nprod = (unsigned)(G / 8);
                    if (xb_add((unsigned*)(ctl + CW_WARR) + 64 * xcc, 1u) + 1u == nprod) { __builtin_amdgcn_fence(__ATOMIC_RELEASE, "agent"); asm volatile("s_waitcnt vmcnt(0)" ::: "memory"); (void)xb_add((unsigned*)(ctl + CW_WDONE), 1u); } }
            }
        }
        if (BOTH(1)) LOCAL_BAR();
    }
    if (IN(2)) {
        FRESH_TID(t2);
        p2_table(args, lds, t2);
#pragma unroll 1
        for (int rep = 0; rep < DUP(2); ++rep)
        for (int u = vcu; u < M / 64; u += G) p2_unit(args, lds, u, t2, wave);
        if (BOTH(2)) LOCAL_BAR();
    }
    if (IN(3)) {
        pg8::Gemm g{Y, Wout_t, M, D, D}; pg8::StaticOrder S; S.init(M, D, G, bx);
        pg8::EpiResH E{args.in[0], XN, SSQ, D};
#pragma unroll 1
        for (int rep = 0; rep < DUP(3); ++rep) { pg8::gemm_phase<pg8::EpiResH, pg8::StaticOrder, false, true>(lds + RING_OFF, g, S, E, wave); if (DUP(3) > 1) __syncthreads(); }
        if (BOTH(3)) {
            const int nwg1 = (M / 256) * (INW / 256), nfull1 = nwg1 % G;
            if (N_LAUNCHES == 1 && regular && (nfull1 % 8) == 0) { ++nlb;
                xcd_local_barrier((unsigned*)(ctl + CW_LBAR) + 64 * xcc, nlb * (unsigned)(G / 8), (unsigned*)(ctl + CW_BAR) + XB_TMO, wave, (unsigned*)(ctl + CW_WDONE), 8u); }
            else GRID_BAR();
        }
    }
    if (IN(4)) {
        pg8::Gemm g{XN, Wup_t, M, NUP, D}; pg8::StaticOrder S; S.init(M, NUP, G, bx);
        pg8::EpiUpConv E{ACT, SSQ, args.in[13], args.in[14], (float*)(ws + WS_BND), (LAS float*)(lds + SCR_OFF)};
        if ((PROBE_NULL >> 4) & 1) { pg8::EpiNullP En{}; pg8::gemm_phase<pg8::EpiNullP, pg8::StaticOrder, true, true>(lds + RING_OFF, g, S, En, wave); __syncthreads(); }
#pragma unroll 1
        for (int rep = 0; rep < DUP(4); ++rep) { pg8::gemm_phase<pg8::EpiUpConv, pg8::StaticOrder, true, true>(lds + RING_OFF, g, S, E, wave); if (DUP(4) > 1) __syncthreads(); }
        if (BOTH(4)) LOCAL_BAR();
    }
    if (IN(5)) {
        pg8::Gemm g{ACT, Wdown_t, M, D, DFF}; pg8::StaticOrder S; S.init(M, D, G, bx);
        { FRESH_TID(tf); pg8::Unit u; for (int i = 0; S.next(i, u); ++i) if (u.pm & 7) fixup_rows(args, u.pm, tf); }
        asm volatile("s_waitcnt vmcnt(0)" ::: "memory"); __syncthreads();
        if (DUP(5) > 1) { pg8::EpiNull En{}; pg8::gemm_phase<pg8::EpiNull, pg8::StaticOrder, false, true>(lds + RING_OFF, g, S, En, wave); __syncthreads(); }
        pg8::EpiResOut E{args.out, XN, D};
        pg8::gemm_phase<pg8::EpiResOut, pg8::StaticOrder, false, true>(lds + RING_OFF, g, S, E, wave);
    }
#undef IN
#undef BOTH
#undef GRID_BAR
#undef LOCAL_BAR
}

extern "C" void kernel_launch(void* const* d_in, const int* in_sizes, int n_in, void* d_out, int out_size, void* d_ws, size_t ws_size, hipStream_t stream) {
    static int grid = 0;
    if (grid == 0) {
        if (n_in != 16 || in_sizes[0] != M * D || out_size != M * D || ws_size < WS_END) { fprintf(stderr, "kernel_launch: unexpected shapes (n_in %d, in0 %d, out %d, ws %zu)\n", n_in, n_in > 0 ? in_sizes[0] : -1, out_size, ws_size); grid = -1; return; }
        int dev = 0, cus = 0, per_cu = 0;
        if (hipGetDevice(&dev) != hipSuccess || hipDeviceGetAttribute(&cus, hipDeviceAttributeMultiprocessorCount, dev) != hipSuccess) { grid = -1; return; }
        if (hipFuncSetAttribute((const void*)mk_fwd, hipFuncAttributeMaxDynamicSharedMemorySize, LDS_BYTES) != hipSuccess) { fprintf(stderr, "kernel_launch: hipFuncSetAttribute failed\n"); grid = -1; return; }
        if (hipOccupancyMaxActiveBlocksPerMultiprocessor(&per_cu, (const void*)mk_fwd, NWAVES * 64, LDS_BYTES) != hipSuccess || per_cu < 1) fprintf(stderr, "kernel_launch: occupancy query reports %d\n", per_cu);
        (void)hipGetLastError();
        grid = cus;
    }
    if (grid < 0) return;
    if (hipMemsetAsync((char*)d_ws + WS_CTL, 0, CTL_ZERO_BYTES, stream) != hipSuccess) return;
    Args a{};
    for (int i = 0; i < 16; ++i) a.in[i] = (const float*)d_in[i];
    a.out = (float*)d_out; a.ws = (unsigned char*)d_ws;
    for (int li = 0; li < N_LAUNCHES; ++li) {
        a.ph_lo = (N_LAUNCHES == 1) ? 0 : li; a.ph_hi = (N_LAUNCHES == 1) ? N_PHASES : li + 1; a.li = li;
        hipLaunchKernelGGL(mk_fwd, dim3(grid), dim3(NWAVES * 64), LDS_BYTES, stream, a);
    }
}
```

```cpp
#include <hip/hip_runtime.h>
#include <cstdio>
#include <cstdint>
__device__ __forceinline__ int lane_id_fresh() { int l; asm volatile("v_mbcnt_lo_u32_b32 %0, -1, 0\n\tv_mbcnt_hi_u32_b32 %0, -1, %0" : "=v"(l)); return l; }
namespace pg8 {
#define PG8_LAS __attribute__((address_space(3)))
typedef unsigned short bf16_t;
typedef short bf16x8 __attribute__((ext_vector_type(8)));
typedef float f32x4 __attribute__((ext_vector_type(4)));
typedef unsigned u32x4 __attribute__((ext_vector_type(4)));
constexpr int BM = 256, BK = 64, HALF = 128, HTB = HALF * BK * 2  , STAGE_BYTES = 8 * HTB, NXCD = 8, WGM = 8;

__host__ __device__ __forceinline__ int lds_byte(int r, int c) { const int st = (r >> 4) * 2 + (c >> 5), rr = r & 15, cc = c & 31, ob = rr * 64 + cc * 2; return st * 1024 + (ob ^ (((ob >> 9) & 1) << 5)); }
__host__ __device__ __forceinline__ void stage_rc(int b, int& R, int& C) { const int st = b / 1024, sb = b % 1024, swz = sb ^ (((sb >> 9) & 1) << 5); R = (st >> 1) * 16 + swz / 64; C = (st & 1) * 32 + (swz % 64) / 2; }
__host__ __device__ __forceinline__ int perm32(int rho) { const int n = rho >> 4, i = rho & 15; return 8 * (i >> 2) + 4 * n + (i & 3); }

struct Unit { int pm, pn; };
struct Gemm { const bf16_t* A; const bf16_t* Bt; int M, N, K; };

struct StaticOrder {
    int nM, nN, nwg, G, c;
    __host__ __device__ void init(int M, int N, int G_, int c_) { nM = M / BM; nN = N / BM; nwg = nM * nN; G = G_; c = c_; }
    __host__ __device__ bool next(int i, Unit& u) const {
        const long L = (long)i * G + c; if (L >= nwg) return false;
        int wgid = (int)L; { const int q = nwg / NXCD, r = nwg % NXCD, xcd = wgid % NXCD, off = wgid / NXCD; wgid = (xcd < r ? xcd * (q + 1) : r * (q + 1) + (xcd - r) * q) + off; }
        const int nig = WGM * nN, gid = wgid / nig, fm = gid * WGM, gsz = (nM - fm) < WGM ? (nM - fm) : WGM;
        u.pm = fm + ((wgid % nig) % gsz); u.pn = (wgid % nig) / gsz; return true;
    }
    __device__ __forceinline__ void a_ready(const Unit&) const {}
    __device__ __forceinline__ void done(const Unit&) const {}
};

__device__ __forceinline__ unsigned cvt_pk_bf16(float lo, float hi) { unsigned r; asm volatile("v_cvt_pk_bf16_f32 %0, %1, %2" : "=v"(r) : "v"(lo), "v"(hi)); return r; }
typedef float f32x2 __attribute__((ext_vector_type(2)));
struct EpiBf16P {
    static constexpr bool PERM = true, AFTER_DRAIN = false, PREFETCH = false;
    static constexpr int SP = 528;
    bf16_t* O; int ldc; PG8_LAS unsigned char* slab;
    __device__ __forceinline__ void operator()(const f32x4 (&acc)[2][2][4][2], const Unit& u, int wr, int wc, int fr_, int fq_) const {
        int fr = fr_, fq = fq_; asm volatile("" : "+v"(fr), "+v"(fq));
        const int tid = (wr * 4 + wc) * 64 + fq * 16 + fr, rr = tid >> 5, ch = tid & 31;
        PG8_LAS unsigned char* wp = slab + (wr * 16 + fr) * SP + wc * 64 + fq * 16;
        const PG8_LAS unsigned char* rp = slab + rr * SP + ch * 16;
        bf16_t* gp = O + (size_t)(u.pm * BM + rr) * ldc + u.pn * BM + ch * 8;
#pragma unroll
        for (int ai = 0; ai < 2; ++ai)
#pragma unroll
            for (int m = 0; m < 4; ++m) {
#pragma unroll
                for (int bj = 0; bj < 2; ++bj) { const f32x4 v0 = acc[ai][bj][m][0], v1 = acc[ai][bj][m][1];
                    u32x4 w; w.x = cvt_pk_bf16(v0[0], v0[1]); w.y = cvt_pk_bf16(v0[2], v0[3]); w.z = cvt_pk_bf16(v1[0], v1[1]); w.w = cvt_pk_bf16(v1[2], v1[3]);
                    *(PG8_LAS u32x4*)(wp + bj * 256) = w; }
                asm volatile("s_waitcnt lgkmcnt(0)" ::: "memory"); __builtin_amdgcn_s_barrier(); asm volatile("" ::: "memory");
                const u32x4 a = *(const PG8_LAS u32x4*)rp, b = *(const PG8_LAS u32x4*)(rp + 16 * SP);
                *(u32x4*)(gp + (size_t)(ai * HALF + m * 16) * ldc) = a; *(u32x4*)(gp + (size_t)(ai * HALF + m * 16 + 64) * ldc) = b;
                asm volatile("s_waitcnt lgkmcnt(0)" ::: "memory"); __builtin_amdgcn_s_barrier(); asm volatile("" ::: "memory");
            }
    }
};
struct EpiBf16Rs {
    static constexpr bool PERM = true, AFTER_DRAIN = false, PREFETCH = false;
    bf16_t* O; int ldc; const float* ssq; int row_off;
    __device__ __forceinline__ void operator()(const f32x4 (&acc)[2][2][4][2], const Unit& u, int wr, int wc, int fr, int fq) const {
        const int row0 = u.pm * BM + wr * 64 + fr, col0 = u.pn * BM + wc * 32 + 8 * fq;
#pragma unroll
        for (int ai = 0; ai < 2; ++ai)
#pragma unroll
            for (int m = 0; m < 4; ++m) { const int row = row0 + ai * HALF + m * 16; bf16_t* rowp = O + (size_t)row * ldc + col0;
                const f32x4 s = *(const f32x4*)(ssq + (size_t)(row + row_off) * 4); const float rs = 1.0f / sqrtf(((s[0] + s[1]) + (s[2] + s[3])) * (1.0f / 1024.0f) + 1e-6f);
#pragma unroll
                for (int bj = 0; bj < 2; ++bj) { const f32x4 v0 = acc[ai][bj][m][0] * rs, v1 = acc[ai][bj][m][1] * rs;
                    u32x4 w; w.x = cvt_pk_bf16(v0[0], v0[1]); w.y = cvt_pk_bf16(v0[2], v0[3]); w.z = cvt_pk_bf16(v1[0], v1[1]); w.w = cvt_pk_bf16(v1[2], v1[3]);
                    *(u32x4*)(rowp + bj * HALF) = w; } }
    }
};
struct EpiResH {
    static constexpr bool PERM = false, AFTER_DRAIN = true, PREFETCH = false;
    const float* base; bf16_t* hb; float* ssq; int ldc;
    __device__ __forceinline__ void fused(f32x4 (&acc)[2][2][4][2], const Unit& u, int wr, int wc, int fr, int fq, PG8_LAS unsigned char* lds, int wid, int lane) const {
        typedef unsigned u32x2v __attribute__((ext_vector_type(2)));
        PG8_LAS float* P = (PG8_LAS float*)lds;
        const int col0 = u.pn * BM + wc * 32 + 4 * fq;
#pragma unroll
        for (int ai = 0; ai < 2; ++ai)
#pragma unroll
            for (int m = 0; m < 4; ++m) { const int r = ai * HALF + wr * 64 + m * 16 + fr; const size_t off = (size_t)(u.pm * BM + r) * ldc + col0; float q = 0.f;
#pragma unroll
                for (int bj = 0; bj < 2; ++bj)
#pragma unroll
                    for (int n = 0; n < 2; ++n) { const f32x4 hv = *(const f32x4*)(base + off + bj * HALF + n * 16) + acc[ai][bj][m][n];
                        q += (hv[0] * hv[0] + hv[1] * hv[1]) + (hv[2] * hv[2] + hv[3] * hv[3]);
                        u32x2v w; w.x = cvt_pk_bf16(hv[0], hv[1]); w.y = cvt_pk_bf16(hv[2], hv[3]); *(u32x2v*)(hb + off + bj * HALF + n * 16) = w; }
                q += __shfl_xor(q, 16); q += __shfl_xor(q, 32);
                if (fq == 0) P[r * 4 + wc] = q;
                if (m & 1) asm volatile("" ::: "memory"); }
        asm volatile("s_waitcnt lgkmcnt(0)" ::: "memory"); __builtin_amdgcn_s_barrier(); asm volatile("" ::: "memory");
        const int tid = wid * 64 + lane;
        if (tid < 256) { const f32x4 p = *(const PG8_LAS f32x4*)(P + tid * 4); ssq[(size_t)(u.pm * BM + tid) * 4 + u.pn] = (p[0] + p[1]) + (p[2] + p[3]); }
    }
};
struct EpiResOut {
    static constexpr bool PERM = false, AFTER_DRAIN = false, PREFETCH = false;
    float* out; const bf16_t* hb; int ldc;
    __device__ __forceinline__ void operator()(const f32x4 (&acc)[2][2][4][2], const Unit& u, int wr, int wc, int fr, int fq) const {
        typedef unsigned u32x2v __attribute__((ext_vector_type(2)));
        const int row0 = u.pm * BM + wr * 64 + fr, col0 = u.pn * BM + wc * 32 + 4 * fq;
#pragma unroll
        for (int ai = 0; ai < 2; ++ai)
#pragma unroll
            for (int m = 0; m < 4; ++m) { const size_t off = (size_t)(row0 + ai * HALF + m * 16) * ldc + col0;
#pragma unroll
                for (int bj = 0; bj < 2; ++bj)
#pragma unroll
                    for (int n = 0; n < 2; ++n) { const u32x2v w = *(const u32x2v*)(hb + off + bj * HALF + n * 16);
                        f32x4 hv; hv[0] = __builtin_bit_cast(float, w.x << 16); hv[1] = __builtin_bit_cast(float, w.x & 0xffff0000u); hv[2] = __builtin_bit_cast(float, w.y << 16); hv[3] = __builtin_bit_cast(float, w.y & 0xffff0000u);
                        *(f32x4*)(out + off + bj * HALF + n * 16) = hv + acc[ai][bj][m][n]; }
                if (m & 1) asm volatile("" ::: "memory"); }
    }
};
template <int CTRL> __device__ __forceinline__ f32x4 dpp4(const f32x4 v) {
    f32x4 r;
#pragma unroll
    for (int e = 0; e < 4; ++e) { const float t = v[e]; const int ti = __builtin_bit_cast(int, t);
        const int ri = __builtin_amdgcn_update_dpp(0, ti, CTRL, 0xf, 0xf, true);
        const float rf = __builtin_bit_cast(float, ri); r[e] = rf; }
    return r;
}
struct EpiUpConv {
    static constexpr bool PERM = true, AFTER_DRAIN = false, PREFETCH = true;
    bf16_t* ACT; const float* ssq; const float* fw; const float* fb; float* bnd; PG8_LAS float* X;
    static constexpr int XC = 4352;
    __device__ __forceinline__ void prefetch(const Unit& u, int wid, int lane) const {
        const float* src;
        if (wid < 4) src = ssq + (size_t)(u.pm * BM + wid * 64 + lane) * 4;
        else { const int c = (wid - 4) * 64 + lane, v = c >> 5, ch4 = c & 31; src = ((v & 3) == 3 ? fb : fw + (size_t)(v & 3) * NUPc) + (v >> 2) * DFFc + u.pn * HALF + ch4 * 4; }
        __builtin_amdgcn_global_load_lds((const unsigned*)src, (PG8_LAS unsigned*)(X + XC + wid * 256), 16, 0, 0);
    }
    static constexpr int NUPc = 5632, DFFc = 2816;
    __device__ __forceinline__ void operator()(f32x4 (&acc)[2][2][4][2], const Unit& u, int wr, int wc, int fr_, int fq_) const {
        int fr = fr_, fq = fq_; asm volatile("" : "+v"(fr), "+v"(fq));
        const int row0 = u.pm * BM + wr * 64 + fr, cw = wc * 32 + 8 * fq;
#pragma unroll
        for (int ai = 0; ai < 2; ++ai)
#pragma unroll
            for (int m = 0; m < 4; ++m) { const int row = row0 + ai * HALF + m * 16;
                const f32x4 s = *(const PG8_LAS f32x4*)(X + XC + (row - u.pm * BM) * 4); const float rs = __builtin_amdgcn_rsqf(((s[0] + s[1]) + (s[2] + s[3])) * (1.0f / 1024.0f) + 1e-6f);
#pragma unroll
                for (int bj = 0; bj < 2; ++bj)
#pragma unroll
                    for (int n = 0; n < 2; ++n) acc[ai][bj][m][n] = acc[ai][bj][m][n] * rs; }
        if (fr >= 14) {
#pragma unroll
            for (int ai = 0; ai < 2; ++ai)
#pragma unroll
                for (int bj = 0; bj < 2; ++bj)
#pragma unroll
                    for (int n = 0; n < 2; ++n) *(PG8_LAS f32x4*)(X + (((2 * ai + wr) * 2 + (fr - 14)) * 256 + bj * HALF + cw + 4 * n)) = acc[ai][bj][3][n];
        }
        { float* bt = bnd + (size_t)u.pm * 4 * NUPc + u.pn * 256;
          if (wr == 0 && fr < 2) {
#pragma unroll
              for (int bj = 0; bj < 2; ++bj)
#pragma unroll
                  for (int n = 0; n < 2; ++n) *(f32x4*)(bt + (size_t)fr * NUPc + bj * HALF + cw + 4 * n) = acc[0][bj][0][n]; }
          if (wr == 1 && fr >= 14) {
#pragma unroll
              for (int bj = 0; bj < 2; ++bj)
#pragma unroll
                  for (int n = 0; n < 2; ++n) *(f32x4*)(bt + (size_t)(2 + fr - 14) * NUPc + bj * HALF + cw + 4 * n) = acc[1][bj][3][n]; } }
        asm volatile("s_waitcnt lgkmcnt(0)" ::: "memory"); __builtin_amdgcn_s_barrier(); asm volatile("" ::: "memory");
        const int ch0 = u.pn * HALF + cw;
        const float ia = fr == 0 ? 0.f : 1.f, im = 1.f - ia; const f32x4 IA = (f32x4){ia, ia, ia, ia}, IM = (f32x4){im, im, im, im};
        unsigned pk[2][4][2][2];
#pragma unroll
        for (int n = 0; n < 2; ++n) {
            f32x4 w0a[2], w0m[2], w1[2], w2[2], b[2];
#pragma unroll
            for (int bj = 0; bj < 2; ++bj) { const PG8_LAS float* cp = X + XC + 1024 + (bj * 4) * 128 + cw + 4 * n;
                const f32x4 w0 = *(const PG8_LAS f32x4*)cp; w1[bj] = *(const PG8_LAS f32x4*)(cp + 128); w2[bj] = *(const PG8_LAS f32x4*)(cp + 256); b[bj] = *(const PG8_LAS f32x4*)(cp + 384);
                w0a[bj] = w0 * ia; w0m[bj] = w0 * im; }
#pragma unroll
            for (int ai = 0; ai < 2; ++ai) {
                const int g = 2 * ai + wr;
                f32x4 r1xp[2], r1tp[2];
#pragma unroll
                for (int bj = 0; bj < 2; ++bj) {
                    if (g > 0) { const f32x4 x2p = *(const PG8_LAS f32x4*)(X + (((g - 1) * 2 + 0) * 256 + bj * HALF + cw + 4 * n)); r1xp[bj] = *(const PG8_LAS f32x4*)(X + (((g - 1) * 2 + 1) * 256 + bj * HALF + cw + 4 * n));
                        r1tp[bj] = w1[bj] * r1xp[bj] + (w0a[bj] + w0m[bj]) * x2p; }
                    else { r1xp[bj] = (f32x4){0.f, 0.f, 0.f, 0.f}; r1tp[bj] = (f32x4){0.f, 0.f, 0.f, 0.f}; } }
#pragma unroll
                for (int m = 0; m < 4; ++m) {
                    f32x4 o[2];
#pragma unroll
                    for (int bj = 0; bj < 2; ++bj) { const f32x4 cur = acc[ai][bj][m][n]; const f32x4 r1x = dpp4<0x121>(cur);
                        const f32x4 t = __builtin_elementwise_fma(w0m[bj], r1xp[bj], __builtin_elementwise_fma(w0a[bj], r1x, w1[bj] * cur)); const f32x4 r1t = dpp4<0x121>(t);
                        o[bj] = __builtin_elementwise_fma(r1t, IA, __builtin_elementwise_fma(r1tp[bj], IM, __builtin_elementwise_fma(w2[bj], cur, b[bj]))); r1xp[bj] = r1x; r1tp[bj] = r1t; }
                    const f32x4 e2 = o[0] * -1.4426950408889634f; f32x4 sg;
#pragma unroll
                    for (int e = 0; e < 4; ++e) sg[e] = __builtin_amdgcn_rcpf(1.0f + __builtin_amdgcn_exp2f(e2[e]));
                    const f32x4 a = (o[0] * o[1]) * sg;
                    pk[ai][m][n][0] = cvt_pk_bf16(a[0], a[1]); pk[ai][m][n][1] = cvt_pk_bf16(a[2], a[3]);
                }
            }
        }
        {
            const int tid = (wr * 4 + wc) * 64 + fq * 16 + fr, rr = tid >> 4, chn = tid & 15;
            PG8_LAS unsigned char* sl = (PG8_LAS unsigned char*)X;
            PG8_LAS unsigned char* wp = sl + (wr * 16 + fr) * 272 + wc * 64 + fq * 16;
            const PG8_LAS unsigned char* rp = sl + rr * 272 + chn * 16;
            bf16_t* gp = ACT + (size_t)(u.pm * BM + (rr >> 4) * 64 + (rr & 15)) * DFFc + u.pn * HALF + chn * 8;
#pragma unroll
            for (int ai = 0; ai < 2; ++ai)
#pragma unroll
                for (int m = 0; m < 4; ++m) { const int so = ((ai * 4 + m + 1) & 1) * (32 * 272);
                    u32x4 wv; wv.x = pk[ai][m][0][0]; wv.y = pk[ai][m][0][1]; wv.z = pk[ai][m][1][0]; wv.w = pk[ai][m][1][1];
                    *(PG8_LAS u32x4*)(wp + so) = wv;
                    asm volatile("s_waitcnt lgkmcnt(0)" ::: "memory"); __builtin_amdgcn_s_barrier(); asm volatile("" ::: "memory");
                    *(u32x4*)(gp + (size_t)(ai * HALF + m * 16) * DFFc) = *(const PG8_LAS u32x4*)(rp + so); }
        }
    }
};
struct EpiNull {
    static constexpr bool PERM = false, AFTER_DRAIN = false, PREFETCH = false;
    __device__ __forceinline__ void operator()(const f32x4 (&acc)[2][2][4][2], const Unit&, int, int, int, int) const {
#pragma unroll
        for (int ai = 0; ai < 2; ++ai)
#pragma unroll
            for (int bj = 0; bj < 2; ++bj)
#pragma unroll
                for (int m = 0; m < 4; ++m)
#pragma unroll
                    for (int n = 0; n < 2; ++n) asm volatile("" :: "v"(acc[ai][bj][m][n]));
    }
};
struct EpiNullP {
    static constexpr bool PERM = true, AFTER_DRAIN = false, PREFETCH = false;
    __device__ __forceinline__ void operator()(const f32x4 (&acc)[2][2][4][2], const Unit&, int, int, int, int) const {
#pragma unroll
        for (int ai = 0; ai < 2; ++ai)
#pragma unroll
            for (int bj = 0; bj < 2; ++bj)
#pragma unroll
                for (int m = 0; m < 4; ++m)
#pragma unroll
                    for (int n = 0; n < 2; ++n) asm volatile("" :: "v"(acc[ai][bj][m][n]));
    }
};
struct EpiDummyContig {
    static constexpr bool PERM = true, AFTER_DRAIN = false, PREFETCH = false;
    bf16_t* O; int npn;
    __device__ __forceinline__ void operator()(const f32x4 (&acc)[2][2][4][2], const Unit& u, int wr, int wc, int fr, int fq) const {
        bf16_t* base = O + (size_t)(u.pm * npn + u.pn) * 65536 + (wr * 4 + wc) * 8192 + (fq * 16 + fr) * 8;
#pragma unroll
        for (int ai = 0; ai < 2; ++ai)
#pragma unroll
            for (int m = 0; m < 4; ++m)
#pragma unroll
                for (int bj = 0; bj < 2; ++bj) { const f32x4 v0 = acc[ai][bj][m][0], v1 = acc[ai][bj][m][1];
                    u32x4 w; w.x = cvt_pk_bf16(v0[0], v0[1]); w.y = cvt_pk_bf16(v0[2], v0[3]); w.z = cvt_pk_bf16(v1[0], v1[1]); w.w = cvt_pk_bf16(v1[2], v1[3]);
                    *(u32x4*)(base + ((ai * 4 + m) * 2 + bj) * 512) = w; }
    }
};
template <class Epi, class Sched, bool ALIGN_EPI = false, bool SP2 = false>
__device__ __forceinline__ void gemm_phase(PG8_LAS unsigned char* lds, const Gemm g, const Sched& S, const Epi& E, const int wave_id  ) {
    int tid_ = wave_id * 64 + lane_id_fresh(); asm volatile("" : "+v"(tid_));
    const int tid = tid_, wid = __builtin_amdgcn_readfirstlane(tid >> 6), lane = tid & 63, wr = wid >> 2, wc = wid & 3, fr = lane & 15, fq = lane >> 4;
    const int K = g.K, nt = K / BK;
    unsigned voffA[2], voffB[2];
#pragma unroll
    for (int i = 0; i < 2; ++i) { int R, C; stage_rc(tid * 16 + i * 8192, R, C); const int Rb = Epi::PERM ? ((R & ~31) + perm32(R & 31)) : R;
        voffA[i] = (unsigned)(R * K + C) * 2u; voffB[i] = (unsigned)(Rb * K + C) * 2u; }
    const size_t kstep = (size_t)(BK * 2);
    const size_t hstep = (size_t)HALF * K * 2;
    const size_t tstep = 2 * hstep;
    const unsigned ldsw = (unsigned)wid * 1024u;
    const int aoff = lds_byte(wr * 64 + fr, fq * 8), boff = lds_byte(wc * 32 + fr, fq * 8);
#define PG8_SA(b, h) (((b) * 2 + (h)) * HTB)
#define PG8_SB(b, h) ((4 + (b) * 2 + (h)) * HTB)
#define PG8_STAGE(bufoff, gbase, voff) do { _Pragma("unroll") for (int _i = 0; _i < 2; ++_i) \
        __builtin_amdgcn_global_load_lds((const unsigned*)((const char*)(gbase) + (voff)[_i]), (PG8_LAS unsigned*)(lds + (bufoff) + ldsw + _i * 8192), 16, 0, 0); } while (0)
#define PG8_LDA(dst, b, h) do { _Pragma("unroll") for (int m = 0; m < 4; ++m) _Pragma("unroll") for (int k = 0; k < 2; ++k) dst[m][k] = *(const PG8_LAS bf16x8*)(lds + PG8_SA(b, h) + aoff + m * 2048 + k * 1024); } while (0)
#define PG8_LDB(dst, b, h) do { _Pragma("unroll") for (int n = 0; n < 2; ++n) _Pragma("unroll") for (int k = 0; k < 2; ++k) dst[n][k] = *(const PG8_LAS bf16x8*)(lds + PG8_SB(b, h) + boff + n * 2048 + k * 1024); } while (0)
#define PG8_MMA(ai, bj, At, Bt) do { __builtin_amdgcn_s_setprio(1); _Pragma("unroll") for (int m = 0; m < 4; ++m) _Pragma("unroll") for (int n = 0; n < 2; ++n) _Pragma("unroll") for (int k = 0; k < 2; ++k) \
        acc[ai][bj][m][n] = __builtin_amdgcn_mfma_f32_16x16x32_bf16(Bt[n][k], At[m][k], acc[ai][bj][m][n], 0, 0, 0); __builtin_amdgcn_s_setprio(0); } while (0)
#define PG8_WAIT_V(n) asm volatile("s_waitcnt vmcnt(" #n ")" ::: "memory")
#define PG8_WAIT_L(n) asm volatile("s_waitcnt lgkmcnt(" #n ")" ::: "memory")
#define PG8_BAR __builtin_amdgcn_s_barrier()
#define PG8_SCHED __builtin_amdgcn_sched_barrier(0)
    Unit cur, nxt; int ui = 0;
    if (!S.next(0, cur)) return;
    f32x4 acc[2][2][4][2];
#pragma unroll
    for (int a = 0; a < 2; ++a)
#pragma unroll
        for (int b = 0; b < 2; ++b)
#pragma unroll
            for (int m = 0; m < 4; ++m)
#pragma unroll
                for (int n = 0; n < 2; ++n) acc[a][b][m][n] = (f32x4){0.f, 0.f, 0.f, 0.f};
    bf16x8 At[4][2], B0[2][2], B1[2][2];
    const char* cA = (const char*)g.A + (size_t)cur.pm * tstep; const char* cB = (const char*)g.Bt + (size_t)cur.pn * tstep;
    S.a_ready(cur);
    if constexpr (SP2) {
        PG8_STAGE(PG8_SB(0, 0), cB, voffB); PG8_STAGE(PG8_SB(0, 1), cB + hstep, voffB); PG8_STAGE(PG8_SA(0, 0), cA, voffA); PG8_STAGE(PG8_SA(0, 1), cA + hstep, voffA);
        if (wr == 1) PG8_BAR;
        PG8_WAIT_V(2); PG8_BAR;
        PG8_STAGE(PG8_SB(1, 0), cB + kstep, voffB); PG8_STAGE(PG8_SA(1, 0), cA + kstep, voffA); PG8_STAGE(PG8_SB(1, 1), cB + hstep + kstep, voffB);
        PG8_WAIT_V(6); PG8_BAR;
    } else {
        PG8_STAGE(PG8_SB(0, 0), cB, voffB); PG8_STAGE(PG8_SA(0, 0), cA, voffA); PG8_STAGE(PG8_SB(0, 1), cB + hstep, voffB); PG8_STAGE(PG8_SA(0, 1), cA + hstep, voffA);
        if (wr == 1) PG8_BAR;
        PG8_WAIT_V(4); PG8_BAR;
        PG8_STAGE(PG8_SB(1, 0), cB + kstep, voffB); PG8_STAGE(PG8_SA(1, 0), cA + kstep, voffA); PG8_STAGE(PG8_SB(1, 1), cB + hstep + kstep, voffB);
        PG8_WAIT_V(6); PG8_BAR;
    }
    for (;;) {
        const bool has_next = S.next(ui + 1, nxt);
        const char* nA = has_next ? (const char*)g.A + (size_t)nxt.pm * tstep : cA; const char* nB = has_next ? (const char*)g.Bt + (size_t)nxt.pn * tstep : cB;
        for (int t = 0; t < nt; t += 2) {
            const bool last = (t == nt - 2);
            const char* a1 = cA + (size_t)(t + 1) * kstep;
            const char* a2 = last ? nA : cA + (size_t)(t + 2) * kstep; const char* b2 = last ? nB : cB + (size_t)(t + 2) * kstep;
            const char* a3 = a2 + kstep; const char* b3 = b2 + kstep;
            if (last && has_next) S.a_ready(nxt);
            if constexpr (Epi::PREFETCH) { if (last) E.prefetch(cur, wid, lane); }
            if constexpr (SP2) {
            PG8_LDB(B0, 0, 0); PG8_LDB(B1, 0, 1); PG8_SCHED; PG8_LDA(At, 0, 0); PG8_STAGE(PG8_SA(1, 1), a1 + hstep, voffA);
            PG8_WAIT_V(8); PG8_WAIT_L(0); PG8_BAR; PG8_MMA(0, 0, At, B0); PG8_MMA(0, 1, At, B1); PG8_BAR; PG8_SCHED;
            PG8_LDA(At, 0, 1); PG8_STAGE(PG8_SB(0, 0), b2, voffB); PG8_STAGE(PG8_SB(0, 1), b2 + hstep, voffB); PG8_STAGE(PG8_SA(0, 0), a2, voffA);
            PG8_WAIT_V(8); PG8_WAIT_L(0); PG8_BAR; PG8_MMA(1, 0, At, B0); PG8_MMA(1, 1, At, B1); PG8_BAR; PG8_SCHED;
            PG8_LDB(B0, 1, 0); PG8_LDB(B1, 1, 1); PG8_SCHED; PG8_LDA(At, 1, 0); PG8_STAGE(PG8_SA(0, 1), a2 + hstep, voffA);
            PG8_WAIT_V(8); PG8_WAIT_L(0); PG8_BAR; PG8_MMA(0, 0, At, B0); PG8_MMA(0, 1, At, B1); PG8_BAR; PG8_SCHED;
            PG8_LDA(At, 1, 1); PG8_STAGE(PG8_SB(1, 0), b3, voffB); PG8_STAGE(PG8_SB(1, 1), b3 + hstep, voffB); PG8_STAGE(PG8_SA(1, 0), a3, voffA);
            PG8_WAIT_V(8); PG8_WAIT_L(0); PG8_BAR; PG8_MMA(1, 0, At, B0); PG8_MMA(1, 1, At, B1); PG8_BAR; PG8_SCHED;
            } else {
            PG8_LDB(B0, 0, 0); PG8_SCHED; PG8_LDA(At, 0, 0); PG8_STAGE(PG8_SA(1, 1), a1 + hstep, voffA);
            PG8_WAIT_L(8); PG8_BAR; PG8_WAIT_L(0); PG8_MMA(0, 0, At, B0); PG8_BAR; PG8_SCHED;
            PG8_LDB(B1, 0, 1); PG8_STAGE(PG8_SB(0, 0), b2, voffB);
            PG8_BAR; PG8_WAIT_L(0); PG8_MMA(0, 1, At, B1); PG8_BAR;
            PG8_LDA(At, 0, 1); PG8_STAGE(PG8_SA(0, 0), a2, voffA);
            PG8_BAR; PG8_WAIT_L(0); PG8_MMA(1, 0, At, B0); PG8_BAR; PG8_SCHED;
            PG8_STAGE(PG8_SB(0, 1), b2 + hstep, voffB);
            PG8_WAIT_V(6); PG8_BAR; PG8_MMA(1, 1, At, B1); PG8_BAR;
            PG8_LDB(B0, 1, 0); PG8_SCHED; PG8_LDA(At, 1, 0); PG8_STAGE(PG8_SA(0, 1), a2 + hstep, voffA);
            PG8_WAIT_L(8); PG8_BAR; PG8_WAIT_L(0); PG8_MMA(0, 0, At, B0); PG8_BAR; PG8_SCHED;
            PG8_LDB(B1, 1, 1); PG8_STAGE(PG8_SB(1, 0), b3, voffB);
            PG8_BAR; PG8_WAIT_L(0); PG8_MMA(0, 1, At, B1); PG8_BAR;
            PG8_LDA(At, 1, 1); PG8_STAGE(PG8_SA(1, 0), a3, voffA);
            PG8_BAR; PG8_WAIT_L(0); PG8_MMA(1, 0, At, B0); PG8_BAR; PG8_SCHED;
            PG8_STAGE(PG8_SB(1, 1), b3 + hstep, voffB);
            PG8_WAIT_V(6); PG8_BAR; PG8_MMA(1, 1, At, B1); PG8_BAR;
            }
        }
        if constexpr (ALIGN_EPI) { if (wr == 0) PG8_BAR; }
        if constexpr (!Epi::AFTER_DRAIN) { E(acc, cur, wr, wc, fr, fq); S.done(cur); }
        if (!has_next) break;
#pragma unroll
        for (int a = 0; a < 2; ++a)
#pragma unroll
            for (int b = 0; b < 2; ++b)
#pragma unroll
                for (int m = 0; m < 4; ++m)
#pragma unroll
                    for (int n = 0; n < 2; ++n) acc[a][b][m][n] = (f32x4){0.f, 0.f, 0.f, 0.f};
        cur = nxt; cA = nA; cB = nB; ++ui;
        if constexpr (ALIGN_EPI) { if (wr == 1) PG8_BAR; }
    }
    PG8_WAIT_V(0);
    if constexpr (!ALIGN_EPI) { if (wr == 0) PG8_BAR; }
    PG8_BAR;
    if constexpr (Epi::AFTER_DRAIN) { E.fused(acc, cur, wr, wc, fr, fq, lds, wid, lane); S.done(cur); }
#undef PG8_SA
#undef PG8_SB
#undef PG8_STAGE
#undef PG8_LDA
#undef PG8_LDB
#undef PG8_MMA
#undef PG8_WAIT_V
#undef PG8_WAIT_L
#undef PG8_BAR
#undef PG8_SCHED
}
}
#define GAS __attribute__((address_space(1)))
#define LAS __attribute__((address_space(3)))
typedef unsigned short bf16;
typedef unsigned v4u __attribute__((ext_vector_type(4)));
typedef float f32x4 __attribute__((ext_vector_type(4)));
typedef short bf16x8 __attribute__((ext_vector_type(8)));
typedef GAS unsigned gu32;
typedef GAS unsigned long long gu64;
#define RLX_AGENT __ATOMIC_RELAXED, __HIP_MEMORY_SCOPE_AGENT
#define LDS_WAIT() asm volatile("s_waitcnt lgkmcnt(0)" ::: "memory")
#define VM_WAIT() asm volatile("s_waitcnt vmcnt(0)" ::: "memory")
__device__ __forceinline__ unsigned long long rt() { return __builtin_amdgcn_s_memrealtime(); }
__device__ __forceinline__ unsigned f2bf(float f) { unsigned u = __builtin_bit_cast(unsigned, f); return (u + 0x7fffu + ((u >> 16) & 1u)) >> 16; }
__device__ __forceinline__ unsigned pk2(float lo, float hi) { return f2bf(lo) | (f2bf(hi) << 16); }

#define XB_TMO      128
#define XB_XCNT(j)  (256  + 64 * (j))
#define XB_XSUB(j)  (1280 + 64 * (j))
#define XB_XGEN(j)  (2304 + 64 * (j))
#define XB_TOP      3328
#define XB_TOPGEN   3392
#define XCD_BAR_WORDS 3456
#define XB_SPIN_CAP (1u << 18)

__device__ __forceinline__ unsigned xb_ld(unsigned* p)              { return __hip_atomic_load(p, __ATOMIC_RELAXED, __HIP_MEMORY_SCOPE_AGENT); }
__device__ __forceinline__ unsigned xb_add(unsigned* p, unsigned v) { return __hip_atomic_fetch_add(p, v, __ATOMIC_RELAXED, __HIP_MEMORY_SCOPE_AGENT); }
__device__ __forceinline__ unsigned xb_xcc_id() { return (unsigned)__builtin_amdgcn_s_getreg((3 << 11) | 20) & 0xFu; }
#define XB_SPIN(cond, bar) do { unsigned _sp = 0; while (cond) { __builtin_amdgcn_s_sleep(1); \
    if ((++_sp & 255u) == 0u) { if (xb_ld(&(bar)[XB_TMO])) break; if (_sp > XB_SPIN_CAP) { atomicAdd(&(bar)[XB_TMO], 1u); break; } } } } while (0)

struct XcdBarrier {
    unsigned* bar; unsigned x; int wave;
    volatile LAS unsigned* st;
};

__device__ __forceinline__ bool xb_thread0(int wave) { return wave == 0 && lane_id_fresh() == 0; }
__device__ __forceinline__ XcdBarrier xcd_barrier_post(unsigned* bar, volatile LAS unsigned* st, int wave) {
    XcdBarrier b; b.bar = bar; b.x = xb_xcc_id(); b.st = st; b.wave = wave;
    if (xb_thread0(wave)) (void)xb_add(&bar[XB_XCNT(b.x)], 1u);
    return b;
}
__device__ __forceinline__ void xcd_barrier_complete(unsigned* bar, unsigned x, unsigned& nloc, unsigned& nx) {
    const unsigned G = gridDim.x * gridDim.y * gridDim.z;
    unsigned sum, cnt, mine, sp = 0u;
    for (;;) {
        sum = 0u; cnt = 0u; mine = 0u;
#pragma unroll
        for (unsigned j = 0; j < 16; ++j) { const unsigned c = xb_ld(&bar[XB_XCNT(j)]); sum += c; cnt += (c > 0u) ? 1u : 0u; mine = (j == x) ? c : mine; }
        if (sum == G) break;
        __builtin_amdgcn_s_sleep(1);
        if ((++sp & 255u) == 0u) { if (xb_ld(&bar[XB_TMO])) break; if (sp > XB_SPIN_CAP) { atomicAdd(&bar[XB_TMO], 1u); break; } }
    }
    nloc = mine > 0u ? mine : 1u; nx = cnt > 0u ? cnt : 1u;
}

__device__ __forceinline__ void xcd_barrier(const XcdBarrier& b) {
    asm volatile("s_waitcnt vmcnt(0)" ::: "memory");
    __syncthreads();
    if (xb_thread0(b.wave)) {
        unsigned* bar = b.bar;
        __builtin_amdgcn_s_waitcnt(0);
        unsigned nloc = b.st[0], nx = b.st[1];
        if (nloc == 0u) { xcd_barrier_complete(bar, b.x, nloc, nx); b.st[0] = nloc; b.st[1] = nx; }
        const unsigned old = xb_add(&bar[XB_XSUB(b.x)], 1u);
        const unsigned gen = old / nloc;
        if (old + 1u == (gen + 1u) * nloc) {
            __builtin_amdgcn_fence(__ATOMIC_RELEASE, "agent");
            asm volatile("s_waitcnt vmcnt(0)" ::: "memory");
            const unsigned og = xb_add(&bar[XB_TOP], 1u);
            const unsigned tg = og / nx;
            if (og + 1u == (tg + 1u) * nx) xb_add(&bar[XB_TOPGEN], 1u);
            else XB_SPIN(xb_ld(&bar[XB_TOPGEN]) == tg, bar);
            __builtin_amdgcn_fence(__ATOMIC_ACQUIRE, "agent");
            xb_add(&bar[XB_XGEN(b.x)], 1u);
            asm volatile("s_waitcnt vmcnt(0)" ::: "memory");
        } else {
            XB_SPIN(xb_ld(&bar[XB_XGEN(b.x)]) == gen, bar);
            __builtin_amdgcn_fence(__ATOMIC_ACQUIRE, "agent");
            asm volatile("s_waitcnt vmcnt(0)" ::: "memory");
        }
    }
    __syncthreads();
}
constexpr int NWAVES = 8;
#ifndef MK_N_LAUNCHES
#define MK_N_LAUNCHES 1
#endif
constexpr int N_LAUNCHES = MK_N_LAUNCHES;
constexpr int N_PHASES = 6;
#ifndef PROBE_DUP
#define PROBE_DUP 0
#endif
#define DUP(k) (1 + ((PROBE_DUP >> (k)) & 1))
#ifndef PROBE_NULL
#define PROBE_NULL 0
#endif

constexpr int D = 1024, BATCH = 8, SEQ = 2048, M = BATCH * SEQ;
constexpr int CW = 512, HD = 64, NH = 8, NKV = 2, AW = 512, INW = 2304, DFF = 2816, NUP = 2 * DFF;
constexpr int C_GB = 0, C_GC = 512, C_HC = 1024, C_Q = 1536, C_K = 2048, C_V = 2176;
constexpr float EPS = 1e-6f;

constexpr size_t MiB = 1u << 20;
constexpr size_t WS_CTL = 0, CTL_ZERO_BYTES = 1 * MiB;
constexpr size_t WS_WIN = 2 * MiB;
constexpr size_t WS_WOUT = 7 * MiB;
constexpr size_t WS_WUP = 9 * MiB;
constexpr size_t WS_WDOWN = 20 * MiB;
constexpr size_t WS_SSQ = 26 * MiB;
constexpr size_t WS_XN = 32 * MiB;
constexpr size_t WS_PROJ = 64 * MiB;
constexpr size_t WS_Y = 136 * MiB;
constexpr size_t WS_BND = 26 * MiB + 512 * 1024;
constexpr size_t WS_ACT = 64 * MiB;
constexpr size_t WS_END = 168 * MiB;
constexpr int CW_TMO = 0, CW_CODE = 1;
constexpr int CW_BAR = 4096;
constexpr int CW_CEN = 8192;
constexpr int CW_LBAR = 10240;

constexpr int LDS_BYTES = 163840;
constexpr int RING_OFF = 0, RING_BYTES = 131072;
constexpr int SCR_OFF = RING_BYTES;
constexpr int LDSCTL_OFF = LDS_BYTES - 1024, MISC_OFF = LDSCTL_OFF + 320;
constexpr int P2_KP = 72, P2_VP = 196, P2_SP = 520;
constexpr int P2_K_OFF = 0, P2_V_OFF = P2_K_OFF + 2 * 192 * P2_KP * 2, P2_STG_OFF = P2_V_OFF + 128 * P2_VP * 2, P2_TAB_OFF = P2_STG_OFF + 32 * P2_SP * 2;
constexpr int P2_LINV_OFF = P2_TAB_OFF + 8 * 192 * 4, P2_END = P2_LINV_OFF + 8 * 32 * 4;
static_assert(SCR_OFF + 6400 * 4 <= LDSCTL_OFF && 2176 * 4 >= 8192 && 2176 * 4 >= 32 * 272 && SCR_OFF + 32 * 528 <= LDSCTL_OFF && P2_END <= LDSCTL_OFF && (P2_V_OFF % 16) == 0 && (P2_STG_OFF % 16) == 0 && (P2_TAB_OFF % 16) == 0, "LDS map");

__device__ __forceinline__ float bf2f(unsigned short h) { return __builtin_bit_cast(float, (unsigned)h << 16); }
__device__ __forceinline__ float wave_sum(float v) {
#pragma unroll
    for (int o = 1; o < 64; o <<= 1) v += __shfl_xor(v, o);
    return v;
}
__device__ __forceinline__ float wave_max(float v) {
#pragma unroll
    for (int o = 1; o < 64; o <<= 1) v = fmaxf(v, __shfl_xor(v, o));
    return v;
}
__host__ __device__ __forceinline__ int up_src_col(int np) { const int pn = np >> 8, w = np & 255, bj = w >> 7, c = w & 127; return bj * DFF + pn * 128 + c; }
__device__ __forceinline__ int t5_bucket(int d) {
    if (d < 16) return d;
    const int b = 16 + (int)(logf((float)d / 16.f) / 2.0794415416798357f * 16.f);
    return b < 31 ? b : 31;
}

constexpr int P0_TP = 65, P0_SCR_BYTES = 64 * P0_TP * 4;
template <int MODE>
__device__ __forceinline__ void p0_transpose_item(const float* W, const float* scale, int K, int N, bf16* WT, LAS float* scr, int item, int lane) {
    const int nblk = N / 64, kb = item / nblk, nb = item % nblk, k0 = 64 * kb, n0 = 64 * nb;
    const int srcn = (MODE == 1 ? up_src_col(n0) : n0) + 4 * (lane & 15), kr = lane >> 4;
    f32x4 v[16];
#pragma unroll
    for (int i = 0; i < 16; ++i) v[i] = *(const GAS f32x4*)(W + (size_t)(k0 + 4 * i + kr) * N + srcn);
#pragma unroll
    for (int i = 0; i < 16; ++i) { const int kk = 4 * i + kr; f32x4 t = v[i]; if (scale) t = t * scale[k0 + kk]; LAS float* d = scr + kk * P0_TP + 4 * (lane & 15); d[0] = t[0]; d[1] = t[1]; d[2] = t[2]; d[3] = t[3]; }
    LDS_WAIT(); asm volatile("" ::: "memory");
    const int c = lane & 7;
#pragma unroll
    for (int j = 0; j < 8; ++j) { const int n = (lane >> 3) + 8 * j; const LAS float* sp = scr + (8 * c) * P0_TP + n;
        v4u o; o.x = pk2(sp[0 * P0_TP], sp[1 * P0_TP]); o.y = pk2(sp[2 * P0_TP], sp[3 * P0_TP]); o.z = pk2(sp[4 * P0_TP], sp[5 * P0_TP]); o.w = pk2(sp[6 * P0_TP], sp[7 * P0_TP]);
        *(GAS v4u*)(WT + (size_t)(n0 + n) * K + k0 + 8 * c) = o; }
    LDS_WAIT(); asm volatile("" ::: "memory");
}
__device__ __forceinline__ void rms_rows2_to_bf16(const float* xrow, bf16* orow, int lane) {
    const GAS f32x4* xr = (const GAS f32x4*)xrow + lane;
    f32x4 v[2][4]; float s[2] = {0.f, 0.f};
#pragma unroll
    for (int r = 0; r < 2; ++r)
#pragma unroll
        for (int j = 0; j < 4; ++j) v[r][j] = xr[r * (D / 4) + 64 * j];
#pragma unroll
    for (int r = 0; r < 2; ++r)
#pragma unroll
        for (int j = 0; j < 4; ++j) s[r] += (v[r][j].x * v[r][j].x + v[r][j].y * v[r][j].y) + (v[r][j].z * v[r][j].z + v[r][j].w * v[r][j].w);
#pragma unroll
    for (int r = 0; r < 2; ++r) {
        const float rstd = 1.f / sqrtf(wave_sum(s[r]) * (1.f / D) + EPS);
        GAS unsigned long long* o8 = (GAS unsigned long long*)(orow + (size_t)r * D) + lane;
#pragma unroll
        for (int j = 0; j < 4; ++j) o8[64 * j] = (unsigned long long)pk2(v[r][j].x * rstd, v[r][j].y * rstd) | ((unsigned long long)pk2(v[r][j].z * rstd, v[r][j].w * rstd) << 32);
    }
}

struct Args { const float* in[16]; float* out; unsigned char* ws; int ph_lo, ph_hi, li, pad; };

constexpr float LOG2E = 1.4426950408889634f;
typedef float f32x16 __attribute__((ext_vector_type(16)));
typedef unsigned u32x2 __attribute__((ext_vector_type(2)));
__device__ __forceinline__ int crow(int r, int hi) { return (r & 3) + 8 * (r >> 2) + 4 * hi; }
__device__ __forceinline__ void unpack8(const v4u w, float (&f)[8]) {
    f[0] = __builtin_bit_cast(float, w.x << 16); f[1] = __builtin_bit_cast(float, w.x & 0xffff0000u); f[2] = __builtin_bit_cast(float, w.y << 16); f[3] = __builtin_bit_cast(float, w.y & 0xffff0000u);
    f[4] = __builtin_bit_cast(float, w.z << 16); f[5] = __builtin_bit_cast(float, w.z & 0xffff0000u); f[6] = __builtin_bit_cast(float, w.w << 16); f[7] = __builtin_bit_cast(float, w.w & 0xffff0000u);
}
__device__ __forceinline__ v4u pack8(const float (&f)[8]) { v4u w; w.x = pg8::cvt_pk_bf16(f[0], f[1]); w.y = pg8::cvt_pk_bf16(f[2], f[3]); w.z = pg8::cvt_pk_bf16(f[4], f[5]); w.w = pg8::cvt_pk_bf16(f[6], f[7]); return w; }

__device__ __forceinline__ void p2_table(const Args& args, LAS unsigned char* lds, int tid) {
    LAS float* rtab = (LAS float*)(lds + P2_TAB_OFF); const float* rel = args.in[6];
    for (int e = tid; e < 8 * 192; e += NWAVES * 64) { const int h = e / 192, i = e % 192, d = 159 - i; rtab[e] = (d >= 0 && d <= 127) ? rel[t5_bucket(d) * NH + h] * LOG2E : -1e30f; }
}
__device__ __forceinline__ void p2_unit(const Args& args, LAS unsigned char* lds, int unit, int tid_in, int wave) {
    const bf16* PROJ = (const bf16*)(args.ws + WS_PROJ); bf16* Y = (bf16*)(args.ws + WS_Y);
    const float* conv_w = args.in[3]; const float* qg = args.in[4]; const float* kg = args.in[5]; const float* sinks = args.in[7];
    const float* gconv = args.in[8]; const float* gattn = args.in[9];
    const int t0 = unit * 64, s0 = t0 & (SEQ - 1);
    {
        int lane = tid_in & 63; asm volatile("" : "+v"(lane));
        const int c0 = 8 * lane, tb = t0 + 8 * wave;
        float w0[8], w1[8], w2[8], p2[8], p1[8], y[8][8], ssq[8];
        { const f32x4* cw = (const f32x4*)(conv_w + c0); const f32x4 a0 = cw[0], a1 = cw[1], b0 = cw[CW / 4], b1 = cw[CW / 4 + 1], c0v = cw[2 * CW / 4], c1v = cw[2 * CW / 4 + 1];
#pragma unroll
          for (int k = 0; k < 4; ++k) { w0[k] = a0[k]; w0[4 + k] = a1[k]; w1[k] = b0[k]; w1[4 + k] = b1[k]; w2[k] = c0v[k]; w2[4 + k] = c1v[k]; } }
        v4u rg[10], rh[10], rb[8];
        const bool halo = !(s0 == 0 && wave == 0);
#pragma unroll
        for (int i = 0; i < 10; ++i) { const bf16* r = PROJ + (size_t)(tb - 2 + i) * INW + c0;
            if (i >= 2 || halo) { rg[i] = *(const v4u*)(r + C_GC); rh[i] = *(const v4u*)(r + C_HC); } else { rg[i] = (v4u){0u, 0u, 0u, 0u}; rh[i] = (v4u){0u, 0u, 0u, 0u}; }
            if (i >= 2) rb[i - 2] = *(const v4u*)(r + C_GB); }
        { float a[8], b[8]; unpack8(rg[0], a); unpack8(rh[0], b);
#pragma unroll
          for (int k = 0; k < 8; ++k) p2[k] = a[k] * b[k];
          unpack8(rg[1], a); unpack8(rh[1], b);
#pragma unroll
          for (int k = 0; k < 8; ++k) p1[k] = a[k] * b[k]; }
#pragma unroll
        for (int i = 0; i < 8; ++i) {
            float a[8], b[8], g[8]; unpack8(rg[i + 2], a); unpack8(rh[i + 2], b); unpack8(rb[i], g);
            float ss = 0.f;
#pragma unroll
            for (int k = 0; k < 8; ++k) { const float p0 = a[k] * b[k]; const float v = g[k] * (w0[k] * p2[k] + w1[k] * p1[k] + w2[k] * p0); y[i][k] = v; ss += v * v; p2[k] = p1[k]; p1[k] = p0; }
            ssq[i] = wave_sum(ss);
        }
        float gc[8]; { const f32x4* gp = (const f32x4*)(gconv + c0); const f32x4 a0 = gp[0], a1 = gp[1];
#pragma unroll
          for (int k = 0; k < 4; ++k) { gc[k] = a0[k]; gc[4 + k] = a1[k]; } }
#pragma unroll
        for (int i = 0; i < 8; ++i) {
            const float rs = 1.0f / sqrtf(ssq[i] * (1.f / CW) + EPS); float o[8];
#pragma unroll
            for (int k = 0; k < 8; ++k) o[k] = y[i][k] * rs * gc[k];
            *(GAS v4u*)(Y + (size_t)(tb + i) * D + c0) = pack8(o);
        }
    }
    {
        int tid = tid_in, lane = tid_in & 63; asm volatile("" : "+v"(tid), "+v"(lane));
        v4u kraw[6], vraw[6];
#pragma unroll
        for (int it = 0; it < 6; ++it) {
            const int c = it * 512 + tid, ch8 = c & 7, kr = c >> 3, key = kr % 192, kvh = kr / 192;
            kraw[it] = (v4u){0u, 0u, 0u, 0u};
            if (s0 - 128 + key >= 0) kraw[it] = *(const v4u*)(PROJ + (size_t)(t0 - 128 + key) * INW + C_K + kvh * HD + ch8 * 8);
        }
#pragma unroll
        for (int it = 0; it < 6; ++it) {
            const int item = it * 8 + wave, kvh = item / 24, rem = item % 24, ch8 = rem / 3, key = (rem % 3) * 64 + lane;
            vraw[it] = (v4u){0u, 0u, 0u, 0u};
            if (s0 - 128 + key >= 0) vraw[it] = *(const v4u*)(PROJ + (size_t)(t0 - 128 + key) * INW + C_V + kvh * HD + ch8 * 8);
        }
#pragma unroll
        for (int it = 0; it < 6; ++it) {
            const int c = it * 512 + tid, ch8 = c & 7, kr = c >> 3, key = kr % 192, kvh = kr / 192;
            float f[8]; unpack8(kraw[it], f);
            float ss = 0.f;
#pragma unroll
            for (int k = 0; k < 8; ++k) ss += f[k] * f[k];
            ss += __shfl_xor(ss, 1); ss += __shfl_xor(ss, 2); ss += __shfl_xor(ss, 4);
            const float rs = 1.0f / sqrtf(ss * (1.f / HD) + EPS);
            const f32x4* kgp = (const f32x4*)(kg + ch8 * 8); const f32x4 g0 = kgp[0], g1 = kgp[1];
#pragma unroll
            for (int k = 0; k < 4; ++k) { f[k] *= rs * g0[k]; f[4 + k] *= rs * g1[k]; }
            *(LAS v4u*)(lds + P2_K_OFF + ((kvh * 192 + key) * P2_KP + ch8 * 8) * 2) = pack8(f);
        }
#pragma unroll
        for (int it = 0; it < 6; ++it) {
            const int item = it * 8 + wave, kvh = item / 24, rem = item % 24, ch8 = rem / 3, key = (rem % 3) * 64 + lane;
            const v4u raw = vraw[it];
            LAS unsigned short* vt = (LAS unsigned short*)(lds + P2_V_OFF) + (kvh * HD + ch8 * 8) * P2_VP + key;
            vt[0 * P2_VP] = (unsigned short)(raw.x & 0xffffu); vt[1 * P2_VP] = (unsigned short)(raw.x >> 16); vt[2 * P2_VP] = (unsigned short)(raw.y & 0xffffu); vt[3 * P2_VP] = (unsigned short)(raw.y >> 16);
            vt[4 * P2_VP] = (unsigned short)(raw.z & 0xffffu); vt[5 * P2_VP] = (unsigned short)(raw.z >> 16); vt[6 * P2_VP] = (unsigned short)(raw.w & 0xffffu); vt[7 * P2_VP] = (unsigned short)(raw.w >> 16);
        }
    }
    __syncthreads();
    int lane = tid_in & 63; asm volatile("" : "+v"(lane));
    const int h = wave, kvh = h >> 2, l31 = lane & 31, hh = lane >> 5;
    const float sink2 = sinks[h] * LOG2E;
    const LAS float* rtab = (const LAS float*)(lds + P2_TAB_OFF) + h * 192;
    LAS float* linv = (LAS float*)(lds + P2_LINV_OFF) + wave * 32;
    v4u qraw[4];
    { const bf16* qp = PROJ + (size_t)(t0 + l31) * INW + C_Q + h * HD + 8 * hh;
#pragma unroll
      for (int s = 0; s < 4; ++s) qraw[s] = *(const v4u*)(qp + 16 * s); }
#pragma unroll 1
    for (int qb = 0; qb < 2; ++qb) {
        int jlo = (128 - s0 - 32 * qb + 31) >> 5; jlo = jlo < 0 ? 0 : jlo;
        bf16x8 qf[4];
        {
            float f[4][8]; float ss = 0.f;
#pragma unroll
            for (int s = 0; s < 4; ++s) { unpack8(qraw[s], f[s]);
#pragma unroll
                for (int k = 0; k < 8; ++k) ss += f[s][k] * f[s][k]; }
            ss += __shfl_xor(ss, 32);
            const float qs = (1.0f / sqrtf(ss * (1.f / HD) + EPS)) * (0.125f * LOG2E);
#pragma unroll
            for (int s = 0; s < 4; ++s) { const f32x4* gp = (const f32x4*)(qg + 16 * s + 8 * hh); const f32x4 g0 = gp[0], g1 = gp[1];
#pragma unroll
                for (int k = 0; k < 4; ++k) { f[s][k] *= qs * g0[k]; f[s][4 + k] *= qs * g1[k]; }
                qf[s] = __builtin_bit_cast(bf16x8, pack8(f[s])); }
            if (qb == 0) {
                const bf16* qp = PROJ + (size_t)(t0 + 32 + l31) * INW + C_Q + h * HD + 8 * hh;
#pragma unroll
                for (int s = 0; s < 4; ++s) qraw[s] = *(const v4u*)(qp + 16 * s);
            }
        }
        f32x16 P[5];
#pragma unroll
        for (int j = 0; j < 5; ++j) {
            if (j >= jlo) {
                const LAS float* tb = rtab + (31 + 32 * j - l31 + 4 * hh);
#pragma unroll
                for (int r = 0; r < 16; ++r) P[j][r] = tb[(r & 3) + 8 * (r >> 2)];
                const LAS unsigned char* kp = lds + P2_K_OFF + ((kvh * 192 + 32 * (qb + j) + l31) * P2_KP + 8 * hh) * 2;
#pragma unroll
                for (int s = 0; s < 4; ++s) P[j] = __builtin_amdgcn_mfma_f32_32x32x16_bf16(*(const LAS bf16x8*)(kp + 32 * s), qf[s], P[j], 0, 0, 0);
            } else {
#pragma unroll
                for (int r = 0; r < 16; ++r) P[j][r] = -1e30f;
            }
        }
        float mx = sink2;
#pragma unroll
        for (int j = 0; j < 5; ++j)
#pragma unroll
            for (int r = 0; r < 16; ++r) mx = fmaxf(mx, P[j][r]);
        mx = fmaxf(mx, __shfl_xor(mx, 32));
        float sum = 0.f;
#pragma unroll
        for (int j = 0; j < 5; ++j)
#pragma unroll
            for (int r = 0; r < 16; ++r) { const float e = __builtin_amdgcn_exp2f(P[j][r] - mx); P[j][r] = e; sum += e; }
        sum += __shfl_xor(sum, 32); sum += __builtin_amdgcn_exp2f(sink2 - mx);
        if (hh == 0) linv[l31] = 1.0f / sum;
        f32x16 o[2];
#pragma unroll
        for (int r = 0; r < 16; ++r) { o[0][r] = 0.f; o[1][r] = 0.f; }
#pragma unroll
        for (int j = 0; j < 5; ++j) {
            if (j >= jlo) {
#pragma unroll
                for (int s = 0; s < 2; ++s) {
                    v4u pw; pw.x = pg8::cvt_pk_bf16(P[j][8 * s + 0], P[j][8 * s + 1]); pw.y = pg8::cvt_pk_bf16(P[j][8 * s + 2], P[j][8 * s + 3]);
                    pw.z = pg8::cvt_pk_bf16(P[j][8 * s + 4], P[j][8 * s + 5]); pw.w = pg8::cvt_pk_bf16(P[j][8 * s + 6], P[j][8 * s + 7]);
                    const bf16x8 pa = __builtin_bit_cast(bf16x8, pw);
#pragma unroll
                    for (int db = 0; db < 2; ++db) {
                        const LAS unsigned char* vp = lds + P2_V_OFF + ((kvh * HD + 32 * db + l31) * P2_VP + 32 * (qb + j) + 16 * s + 4 * hh) * 2;
                        const u32x2 lo = *(const LAS u32x2*)vp, hi = *(const LAS u32x2*)(vp + 16);
                        v4u vw; vw.x = lo.x; vw.y = lo.y; vw.z = hi.x; vw.w = hi.y;
                        o[db] = __builtin_amdgcn_mfma_f32_32x32x16_bf16(pa, __builtin_bit_cast(bf16x8, vw), o[db], 0, 0, 0);
                    }
                }
            }
        }
        {
            LAS unsigned short* stg = (LAS unsigned short*)(lds + P2_STG_OFF) + h * HD + l31;
#pragma unroll
            for (int r = 0; r < 16; ++r) { const int tk = crow(r, hh); const float li = linv[tk];
                stg[tk * P2_SP] = (unsigned short)f2bf(o[0][r] * li); stg[tk * P2_SP + 32] = (unsigned short)f2bf(o[1][r] * li); }
        }
        __syncthreads();
        {
            float ga[8]; { const f32x4* gp = (const f32x4*)(gattn + 8 * lane); const f32x4 a0 = gp[0], a1 = gp[1];
#pragma unroll
              for (int k = 0; k < 4; ++k) { ga[k] = a0[k]; ga[4 + k] = a1[k]; } }
#pragma unroll
            for (int i = 0; i < 4; ++i) {
                const int tk = 4 * wave + i; float f[8]; unpack8(*(const LAS v4u*)(lds + P2_STG_OFF + (tk * P2_SP + 8 * lane) * 2), f);
                float ss = 0.f;
#pragma unroll
                for (int k = 0; k < 8; ++k) ss += f[k] * f[k];
                const float rs = 1.0f / sqrtf(wave_sum(ss) * (1.f / AW) + EPS);
#pragma unroll
                for (int k = 0; k < 8; ++k) f[k] *= rs * ga[k];
                *(GAS v4u*)(Y + (size_t)(t0 + 32 * qb + tk) * D + CW + 8 * lane) = pack8(f);
            }
        }
        __syncthreads();
    }
}

__device__ __forceinline__ void fixup_rows(const Args& args, int pm, int tid) {
    const float* bnd = (const float*)(args.ws + WS_BND); bf16* ACT = (bf16*)(args.ws + WS_ACT);
    const float* fw = args.in[13]; const float* fb = args.in[14];
    const float* prev = bnd + (size_t)(pm - 1) * 4 * NUP; const float* cur = bnd + (size_t)pm * 4 * NUP;
    for (int item = tid; item < 2 * (DFF / 8); item += NWAVES * 64) {
        const int rsel = item / (DFF / 8), ch0 = (item % (DFF / 8)) * 8, col = (ch0 >> 7) * 256 + (ch0 & 127);
        const float* x2 = prev + (size_t)(2 + rsel) * NUP + col; const float* x1 = (rsel == 0 ? prev + (size_t)3 * NUP : cur) + col; const float* x0 = cur + (size_t)rsel * NUP + col;
        unsigned pk[4];
#pragma unroll
        for (int q = 0; q < 2; ++q) {
            f32x4 o[2];
#pragma unroll
            for (int bj = 0; bj < 2; ++bj) {
                const f32x4 a2 = *(const f32x4*)(x2 + bj * 128 + 4 * q), a1 = *(const f32x4*)(x1 + bj * 128 + 4 * q), a0 = *(const f32x4*)(x0 + bj * 128 + 4 * q);
                const float* wp = fw + bj * DFF + ch0 + 4 * q;
                o[bj] = *(const f32x4*)(fb + bj * DFF + ch0 + 4 * q) + *(const f32x4*)(wp) * a2 + *(const f32x4*)(wp + NUP) * a1 + *(const f32x4*)(wp + 2 * NUP) * a0;
            }
            float a[4];
#pragma unroll
            for (int e = 0; e < 4; ++e) a[e] = o[0][e] * __builtin_amdgcn_rcpf(1.0f + __builtin_amdgcn_exp2f(o[0][e] * -1.4426950408889634f)) * o[1][e];
            pk[2 * q] = pk2(a[0], a[1]); pk[2 * q + 1] = pk2(a[2], a[3]);
        }
        v4u wv; wv.x = pk[0]; wv.y = pk[1]; wv.z = pk[2]; wv.w = pk[3];
        *(GAS v4u*)(ACT + (size_t)(pm * 256 + rsel) * DFF + ch0) = wv;
    }
}

__device__ __forceinline__ void xcd_local_barrier(unsigned* cnt, unsigned target, unsigned* tmo, int wave) {
    asm volatile("s_waitcnt vmcnt(0)" ::: "memory");
    __syncthreads();
    if (xb_thread0(wave)) {
        __builtin_amdgcn_s_waitcnt(0);
        (void)xb_add(cnt, 1u);
        unsigned sp = 0u;
        while (xb_ld(cnt) < target) { __builtin_amdgcn_s_sleep(1); if ((++sp & 255u) == 0u) { if (xb_ld(tmo)) break; if (sp > XB_SPIN_CAP) { atomicAdd(tmo, 1u); break; } } }
        __builtin_amdgcn_fence(__ATOMIC_ACQUIRE, "agent");
        asm volatile("s_waitcnt vmcnt(0)" ::: "memory");
    }
    __syncthreads();
}

__global__ void __launch_bounds__(NWAVES * 64, 2) mk_fwd(Args args) {
    extern __shared__ __attribute__((aligned(16))) unsigned char lds_raw[];
    LAS unsigned char* lds = (LAS unsigned char*)lds_raw;
    volatile LAS unsigned* MISC = (volatile LAS unsigned*)(lds + MISC_OFF);
    const int wave = __builtin_amdgcn_readfirstlane(threadIdx.x >> 6);
#define FRESH_TID(t) int t = wave * 64 + lane_id_fresh(); asm volatile("" : "+v"(t))
    FRESH_TID(tid); const int lane = tid & 63;
    const int G = gridDim.x; const int bx0 = blockIdx.x;
    unsigned char* ws = args.ws;
    gu32* ctl = (gu32*)(ws + WS_CTL);
    bf16* Win_t = (bf16*)(ws + WS_WIN); bf16* Wout_t = (bf16*)(ws + WS_WOUT); bf16* Wup_t = (bf16*)(ws + WS_WUP); bf16* Wdown_t = (bf16*)(ws + WS_WDOWN);
    float* SSQ = (float*)(ws + WS_SSQ); bf16* XN = (bf16*)(ws + WS_XN); bf16* PROJ = (bf16*)(ws + WS_PROJ); bf16* Y = (bf16*)(ws + WS_Y);
    bf16* ACT = (bf16*)(ws + WS_ACT);
    for (int u = tid; u < (LDS_BYTES - LDSCTL_OFF) / 4; u += NWAVES * 64) ((LAS unsigned*)(lds + LDSCTL_OFF))[u] = 0u;
    __syncthreads();
    XcdBarrier bar; bar.bar = (unsigned*)(ctl + CW_BAR); bar.x = 0; bar.st = nullptr; bar.wave = wave;
    if (N_LAUNCHES == 1) bar = xcd_barrier_post((unsigned*)(ctl + CW_BAR), MISC + 8, wave);
    const unsigned xcc = xb_xcc_id();
    if (N_LAUNCHES == 1) { if (xb_thread0(wave)) MISC[10] = xb_add((unsigned*)(ctl + CW_CEN) + 64 * xcc, 1u); __syncthreads(); }
    const unsigned rank = MISC[10];
    int bx = bx0, vcu = (G % 8 == 0) ? (bx0 % 8) * (G / 8) + bx0 / 8 : bx0; bool regular = false; unsigned nlb = 0u;
#define LOCAL_BAR() do { if (N_LAUNCHES == 1) { if (regular) { ++nlb; xcd_local_barrier((unsigned*)(ctl + CW_LBAR) + 64 * xcc, nlb * (unsigned)(G / 8), (unsigned*)(ctl + CW_BAR) + XB_TMO, wave); } else xcd_barrier(bar); } } while (0)
#ifndef PROBE_XBAR
#define PROBE_XBAR 0
#endif
#define GRID_BAR() do { if (N_LAUNCHES == 1) { xcd_barrier(bar); for (int xb_ = 0; xb_ < PROBE_XBAR; ++xb_) xcd_barrier(bar); } } while (0)
    const int lo = args.ph_lo, hi = args.ph_hi;
#define IN(k) (lo <= (k) && (k) < hi)
#define BOTH(k) (IN(k) && IN((k) + 1))

    if (IN(0)) {
#pragma unroll 1
      for (int rep = 0; rep < DUP(0); ++rep) {
        LAS float* scr = (LAS float*)(lds + wave * P0_SCR_BYTES);
        const int gw = vcu * NWAVES + wave, NGW = G * NWAVES;
        constexpr int I_IN = (D / 64) * (INW / 64), I_OUT = (D / 64) * (D / 64);
        for (int it = gw; it < I_IN + I_OUT + M / 2; it += NGW) {
            int r = it;
            if (r < I_IN) { p0_transpose_item<0>(args.in[2], args.in[1], D, INW, Win_t, scr, r, lane); continue; } r -= I_IN;
            if (r < I_OUT) { p0_transpose_item<0>(args.in[10], nullptr, D, D, Wout_t, scr, r, lane); continue; } r -= I_OUT;
            rms_rows2_to_bf16(args.in[0] + (size_t)(2 * r) * D, XN + (size_t)(2 * r) * D, lane);
        }
        if (DUP(0) > 1) __syncthreads();
      }
        if (BOTH(0)) GRID_BAR();
    }
    if (N_LAUNCHES == 1 && (G % 8) == 0) {
        bool reg = xcc < 8u;
#pragma unroll
        for (int j = 0; j < 8; ++j) reg = reg && (xb_ld((unsigned*)(ctl + CW_CEN) + 64 * j) == (unsigned)(G / 8));
        regular = __builtin_amdgcn_readfirstlane(reg ? 1 : 0) != 0;
        if (regular) { bx = (int)(rank * 8u + xcc); vcu = (bx % 8) * (G / 8) + bx / 8; }
    }
    if (IN(1)) {
        pg8::Gemm g{XN, Win_t, M, INW, D}; pg8::StaticOrder S; S.init(M, INW, G, bx);
        pg8::EpiBf16P E{PROJ, INW, lds + SCR_OFF};
        if ((PROBE_NULL >> 8) & 1) { pg8::EpiDummyContig Ed{(bf16*)(ws + WS_Y), INW / 256}; pg8::gemm_phase<pg8::EpiDummyContig, pg8::StaticOrder, true, true>(lds + RING_OFF, g, S, Ed, wave); __syncthreads(); }
        if ((PROBE_NULL >> 1) & 1) { pg8::EpiNullP En{}; pg8::gemm_phase<pg8::EpiNullP, pg8::StaticOrder, true, true>(lds + RING_OFF, g, S, En, wave); __syncthreads(); }
#pragma unroll 1
        for (int rep = 0; rep < DUP(1); ++rep) { pg8::gemm_phase<pg8::EpiBf16P, pg8::StaticOrder, true, true>(lds + RING_OFF, g, S, E, wave); if (DUP(1) > 1) __syncthreads(); }
        {
            const int nwg = (M / 256) * (INW / 256), nfull = nwg % G;
            if (nfull != 0 && bx >= nfull) {
                FRESH_TID(tq); const int lq = tq & 63;
                LAS float* scr = (LAS float*)(lds + wave * P0_SCR_BYTES);
                constexpr int I_UP = (D / 64) * (NUP / 64), I_DN = (DFF / 64) * (D / 64);
                const int gw = (bx - nfull) * NWAVES + wave, NGW = (G - nfull) * NWAVES;
                for (int it = gw; it < I_UP + I_DN; it += NGW) {
                    if (it < I_UP) p0_transpose_item<1>(args.in[12], args.in[11], D, NUP, Wup_t, scr, it, lq);
                    else p0_transpose_item<0>(args.in[15], nullptr, DFF, D, Wdown_t, scr, it - I_UP, lq);
                }
            } else if (nfull == 0) {
                FRESH_TID(tq); const int lq = tq & 63;
                LAS float* scr = (LAS float*)(lds + wave * P0_SCR_BYTES);
                constexpr int I_UP = (D / 64) * (NUP / 64), I_DN = (DFF / 64) * (D / 64);
                for (int it = bx * NWAVES + wave; it < I_UP + I_DN; it += G * NWAVES) {
                    if (it < I_UP) p0_transpose_item<1>(args.in[12], args.in[11], D, NUP, Wup_t, scr, it, lq);
                    else p0_transpose_item<0>(args.in[15], nullptr, DFF, D, Wdown_t, scr, it - I_UP, lq);
                }
            }
        }
        if (BOTH(1)) LOCAL_BAR();
    }
    if (IN(2)) {
        FRESH_TID(t2);
        p2_table(args, lds, t2);
#pragma unroll 1
        for (int rep = 0; rep < DUP(2); ++rep)
        for (int u = vcu; u < M / 64; u += G) p2_unit(args, lds, u, t2, wave);
        if (BOTH(2)) LOCAL_BAR();
    }
    if (IN(3)) {
        pg8::Gemm g{Y, Wout_t, M, D, D}; pg8::StaticOrder S; S.init(M, D, G, bx);
        pg8::EpiResH E{args.in[0], XN, SSQ, D};
#pragma unroll 1
        for (int rep = 0; rep < DUP(3); ++rep) { pg8::gemm_phase<pg8::EpiResH, pg8::StaticOrder, false, true>(lds + RING_OFF, g, S, E, wave); if (DUP(3) > 1) __syncthreads(); }
        if (BOTH(3)) GRID_BAR();
    }
    if (IN(4)) {
        pg8::Gemm g{XN, Wup_t, M, NUP, D}; pg8::StaticOrder S; S.init(M, NUP, G, bx);
        pg8::EpiUpConv E{ACT, SSQ, args.in[13], args.in[14], (float*)(ws + WS_BND), (LAS float*)(lds + SCR_OFF)};
        if ((PROBE_NULL >> 4) & 1) { pg8::EpiNullP En{}; pg8::gemm_phase<pg8::EpiNullP, pg8::StaticOrder, true, true>(lds + RING_OFF, g, S, En, wave); __syncthreads(); }
#pragma unroll 1
        for (int rep = 0; rep < DUP(4); ++rep) { pg8::gemm_phase<pg8::EpiUpConv, pg8::StaticOrder, true, true>(lds + RING_OFF, g, S, E, wave); if (DUP(4) > 1) __syncthreads(); }
        if (BOTH(4)) LOCAL_BAR();
    }
    if (IN(5)) {
        pg8::Gemm g{ACT, Wdown_t, M, D, DFF}; pg8::StaticOrder S; S.init(M, D, G, bx);
        { FRESH_TID(tf); pg8::Unit u; for (int i = 0; S.next(i, u); ++i) if (u.pm & 7) fixup_rows(args, u.pm, tf); }
        asm volatile("s_waitcnt vmcnt(0)" ::: "memory"); __syncthreads();
        if (DUP(5) > 1) { pg8::EpiNull En{}; pg8::gemm_phase<pg8::EpiNull, pg8::StaticOrder, false, true>(lds + RING_OFF, g, S, En, wave); __syncthreads(); }
        pg8::EpiResOut E{args.out, XN, D};
        pg8::gemm_phase<pg8::EpiResOut, pg8::StaticOrder, false, true>(lds + RING_OFF, g, S, E, wave);
    }
#undef IN
#undef BOTH
#undef GRID_BAR
#undef LOCAL_BAR
}

extern "C" void kernel_launch(void* const* d_in, const int* in_sizes, int n_in, void* d_out, int out_size, void* d_ws, size_t ws_size, hipStream_t stream) {
    static int grid = 0;
    if (grid == 0) {
        if (n_in != 16 || in_sizes[0] != M * D || out_size != M * D || ws_size < WS_END) { fprintf(stderr, "kernel_launch: unexpected shapes (n_in %d, in0 %d, out %d, ws %zu)\n", n_in, n_in > 0 ? in_sizes[0] : -1, out_size, ws_size); grid = -1; return; }
        int dev = 0, cus = 0, per_cu = 0;
        if (hipGetDevice(&dev) != hipSuccess || hipDeviceGetAttribute(&cus, hipDeviceAttributeMultiprocessorCount, dev) != hipSuccess) { grid = -1; return; }
        if (hipFuncSetAttribute((const void*)mk_fwd, hipFuncAttributeMaxDynamicSharedMemorySize, LDS_BYTES) != hipSuccess) { fprintf(stderr, "kernel_launch: hipFuncSetAttribute failed\n"); grid = -1; return; }
        if (hipOccupancyMaxActiveBlocksPerMultiprocessor(&per_cu, (const void*)mk_fwd, NWAVES * 64, LDS_BYTES) != hipSuccess || per_cu < 1) fprintf(stderr, "kernel_launch: occupancy query reports %d\n", per_cu);
        (void)hipGetLastError();
        grid = cus;
    }
    if (grid < 0) return;
    if (hipMemsetAsync((char*)d_ws + WS_CTL, 0, CTL_ZERO_BYTES, stream) != hipSuccess) return;
    Args a{};
    for (int i = 0; i < 16; ++i) a.in[i] = (const float*)d_in[i];
    a.out = (float*)d_out; a.ws = (unsigned char*)d_ws;
    for (int li = 0; li < N_LAUNCHES; ++li) {
        a.ph_lo = (N_LAUNCHES == 1) ? 0 : li; a.ph_hi = (N_LAUNCHES == 1) ? N_PHASES : li + 1; a.li = li;
        hipLaunchKernelGGL(mk_fwd, dim3(grid), dim3(NWAVES * 64), LDS_BYTES, stream, a);
    }
}
```
